# Optimizing an MI355X kernel written in HIP

```python
import math
import jax
import jax.numpy as jnp
from jax import lax
import numpy as np

D_MODEL = 1024
BATCH = 16
SEQ = 2048
DEPTH = 2

HEAD_DIM = 64
D_MIX = D_MODEL
POOL_WINDOWS = (2, 4, 8, 16)
POOL_GROUPS = len(POOL_WINDOWS)
POOL_WIDTH = D_MIX // 4
POOL_GROUP_DIM = POOL_WIDTH // POOL_GROUPS
DIFF_WIDTH = D_MIX // 2
DIFF_V_DIM = 2 * HEAD_DIM
DIFF_HEADS = DIFF_WIDTH // DIFF_V_DIM
MOBA_WIDTH = D_MIX - POOL_WIDTH - DIFF_WIDTH
MOBA_HEADS = MOBA_WIDTH // HEAD_DIM
MOBA_BLOCK = 256
MOBA_TOPK = 3
MOBA_Q_CHUNK = 16
ATTN_Q_BLOCK = 128
IN_COLS = POOL_WIDTH + 3 * DIFF_WIDTH + 3 * MOBA_WIDTH
SPLITS = (POOL_WIDTH,
          POOL_WIDTH + DIFF_WIDTH,
          POOL_WIDTH + 2 * DIFF_WIDTH,
          POOL_WIDTH + 3 * DIFF_WIDTH,
          POOL_WIDTH + 3 * DIFF_WIDTH + MOBA_WIDTH,
          POOL_WIDTH + 3 * DIFF_WIDTH + 2 * MOBA_WIDTH)
D_FF = 2816
ROPE_THETA = 10000.0
NORM_EPS = 1e-6
NEG_INF = -1e30

kernel_name = "hybrid_pool_diffattn_moba_macaron"


def rmsnorm(x, g):
    xf = x.astype(jnp.float32)
    y = xf * lax.rsqrt(jnp.mean(xf * xf, axis=-1, keepdims=True) + NORM_EPS)
    return (y * g.astype(jnp.float32)).astype(x.dtype)


def swiglu_ffn(h, w_in, w_out):
    a, b = jnp.split(h @ w_in, 2, axis=-1)
    return (jax.nn.silu(a) * b) @ w_out


def rope_tables(seq):
    inv = ROPE_THETA ** (-jnp.arange(0, HEAD_DIM, 2, dtype=jnp.float32) / HEAD_DIM)
    ang = jnp.arange(seq, dtype=jnp.float32)[:, None] * inv[None, :]
    return jnp.cos(ang), jnp.sin(ang)


def rope(x, cos, sin):
    half = HEAD_DIM // 2
    xf = x.astype(jnp.float32)
    x1, x2 = xf[..., :half], xf[..., half:]
    out = jnp.concatenate([x1 * cos - x2 * sin, x2 * cos + x1 * sin], axis=-1)
    return out.astype(x.dtype)


def pool_mixer(u, pool_w, pool_scale):
    B, S, _ = u.shape
    uf = u.astype(jnp.float32)
    csum = jnp.pad(jnp.cumsum(uf, axis=1), ((0, 0), (1, 0), (0, 0)))
    t = jnp.arange(S)
    outs = []
    for g, w in enumerate(POOL_WINDOWS):
        c = csum[:, :, g * POOL_GROUP_DIM:(g + 1) * POOL_GROUP_DIM]
        start = jnp.maximum(t + 1 - w, 0)
        count = jnp.minimum(t + 1, w).astype(jnp.float32)
        outs.append((c[:, 1:] - c[:, start]) / count[None, :, None])
    pooled = (jnp.concatenate(outs, axis=-1) - uf).astype(u.dtype)
    pooled = pooled.reshape(B, S, POOL_GROUPS, POOL_GROUP_DIM)
    mixed = jnp.einsum('bsgc,gcd->bsgd', pooled, pool_w).reshape(B, S, POOL_WIDTH)
    return mixed * pool_scale


def diff_attention(q, k, v, lam, subln_g, lambda_init, cos, sin):
    B, S = q.shape[:2]
    q = rope(q.transpose(0, 2, 3, 1, 4), cos, sin)
    k = rope(k.transpose(0, 2, 3, 1, 4), cos, sin)
    v = v.transpose(0, 2, 1, 3)
    lf = lam.astype(jnp.float32)
    lam_val = jnp.exp(jnp.sum(lf[0] * lf[1])) - jnp.exp(jnp.sum(lf[2] * lf[3])) + lambda_init
    scale = HEAD_DIM ** -0.5
    nblk = S // ATTN_Q_BLOCK
    qb = q.reshape(B, DIFF_HEADS, 2, nblk, ATTN_Q_BLOCK, HEAD_DIM).transpose(3, 0, 1, 2, 4, 5)
    kpos = jnp.arange(S)

    def one_block(args):
        qblk, i = args
        qpos = i * ATTN_Q_BLOCK + jnp.arange(ATTN_Q_BLOCK)
        s = jnp.einsum('bhmqd,bhmkd->bhmqk', qblk, k).astype(jnp.float32) * scale
        s = jnp.where(kpos[None, :] <= qpos[:, None], s, NEG_INF)
        p = jax.nn.softmax(s, axis=-1)
        pdiff = p[:, :, 0] - lam_val * p[:, :, 1]
        return jnp.einsum('bhqk,bhkd->bhqd', pdiff.astype(v.dtype), v)

    o = lax.map(one_block, (qb, jnp.arange(nblk)))
    o = o.transpose(1, 2, 0, 3, 4).reshape(B, DIFF_HEADS, S, DIFF_V_DIM)
    o = rmsnorm(o, subln_g) * (1.0 - lambda_init)
    return o.transpose(0, 2, 1, 3).reshape(B, S, DIFF_WIDTH)


def moba_attention(q, k, v, cos, sin):
    B, S = q.shape[:2]
    H = MOBA_HEADS
    q = rope(q.transpose(0, 2, 1, 3), cos, sin)
    k = rope(k.transpose(0, 2, 1, 3), cos, sin)
    v = v.transpose(0, 2, 1, 3)
    nb = -(-S // MOBA_BLOCK)
    pad = nb * MOBA_BLOCK - S
    kblk = jnp.pad(k, ((0, 0), (0, 0), (0, pad), (0, 0))).reshape(B, H, nb, MOBA_BLOCK, HEAD_DIM)
    vblk = jnp.pad(v, ((0, 0), (0, 0), (0, pad), (0, 0))).reshape(B, H, nb, MOBA_BLOCK, HEAD_DIM)
    kmean = jnp.mean(kblk.astype(jnp.float32), axis=3)
    n_sel = min(MOBA_TOPK, nb - 1)
    scale = HEAD_DIM ** -0.5
    nq = S // MOBA_Q_CHUNK
    qc = q.reshape(B, H, nq, MOBA_Q_CHUNK, HEAD_DIM).transpose(2, 0, 1, 3, 4)
    bi = jnp.arange(B)[:, None, None, None]
    hi = jnp.arange(H)[None, :, None, None]
    key_off = jnp.arange(MOBA_BLOCK)
    blk_ids = jnp.arange(nb)

    def one_chunk(args):
        qblk, i = args
        qpos = i * MOBA_Q_CHUNK + jnp.arange(MOBA_Q_CHUNK)
        own = qpos // MOBA_BLOCK
        own_idx = jnp.broadcast_to(own[None, None, :, None], (B, H, MOBA_Q_CHUNK, 1))
        causal = (own[:, None] * MOBA_BLOCK + key_off[None, :]) <= qpos[:, None]
        own_valid = jnp.broadcast_to(causal[None, None, :, None, :], (B, H, MOBA_Q_CHUNK, 1, MOBA_BLOCK))
        if n_sel > 0:
            gate = jnp.einsum('bhqd,bhnd->bhqn', qblk.astype(jnp.float32), kmean)
            gate = jnp.where(blk_ids[None, :] < own[:, None], gate, NEG_INF)
            _, sel = lax.top_k(gate, n_sel)
            sel_valid = sel < own[None, None, :, None]
            idx = jnp.concatenate([sel.astype(own_idx.dtype), own_idx], axis=-1)
            valid = jnp.concatenate(
                [jnp.broadcast_to(sel_valid[..., None], (B, H, MOBA_Q_CHUNK, n_sel, MOBA_BLOCK)), own_valid],
                axis=3)
        else:
            idx = own_idx
            valid = own_valid
        kg = kblk[bi, hi, idx]
        vg = vblk[bi, hi, idx]
        s = jnp.einsum('bhqd,bhqnkd->bhqnk', qblk, kg).astype(jnp.float32) * scale
        s = jnp.where(valid, s, NEG_INF)
        p = jax.nn.softmax(s.reshape(B, H, MOBA_Q_CHUNK, -1), axis=-1).reshape(s.shape)
        return jnp.einsum('bhqnk,bhqnkd->bhqd', p.astype(vg.dtype), vg)

    o = lax.map(one_chunk, (qc, jnp.arange(nq)))
    o = o.transpose(1, 2, 0, 3, 4).reshape(B, H, S, HEAD_DIM)
    return o.transpose(0, 2, 1, 3).reshape(B, S, MOBA_WIDTH)


def token_mixing(h, w_in, w_out, pool_w, pool_scale, diff_lambda, diff_subln, lambda_init, cos, sin):
    B, S, _ = h.shape
    proj = h @ w_in
    u, dq, dk, dv, mq, mk, mv = jnp.split(proj, SPLITS, axis=-1)
    ya = pool_mixer(u, pool_w, pool_scale)
    yb = diff_attention(dq.reshape(B, S, DIFF_HEADS, 2, HEAD_DIM),
                        dk.reshape(B, S, DIFF_HEADS, 2, HEAD_DIM),
                        dv.reshape(B, S, DIFF_HEADS, DIFF_V_DIM),
                        diff_lambda, diff_subln, lambda_init, cos, sin)
    yc = moba_attention(mq.reshape(B, S, MOBA_HEADS, HEAD_DIM),
                        mk.reshape(B, S, MOBA_HEADS, HEAD_DIM),
                        mv.reshape(B, S, MOBA_HEADS, HEAD_DIM), cos, sin)
    return jnp.concatenate([ya, yb, yc], axis=-1) @ w_out


def setup_inputs(seed: int = 0) -> dict:
    key = jax.random.key(seed)
    ks = jax.random.split(key, 16)
    f32 = jnp.float32

    def nrm(k, shape, scale):
        return jax.random.normal(k, shape, f32) * scale

    def gain(k, shape):
        return 1.0 + 0.05 * jax.random.normal(k, shape, f32)

    return {
        "x": nrm(ks[0], (BATCH, SEQ, D_MODEL), 1.0),
        "ffn1_norm": gain(ks[1], (DEPTH, D_MODEL)),
        "ffn1_w_in": nrm(ks[2], (DEPTH, D_MODEL, 2 * D_FF), D_MODEL ** -0.5),
        "ffn1_w_out": nrm(ks[3], (DEPTH, D_FF, D_MODEL), D_FF ** -0.5),
        "mix_norm": gain(ks[4], (DEPTH, D_MODEL)),
        "mix_w_in": nrm(ks[5], (DEPTH, D_MODEL, IN_COLS), D_MODEL ** -0.5),
        "mix_w_out": nrm(ks[6], (DEPTH, D_MIX, D_MODEL), D_MIX ** -0.5),
        "pool_w": nrm(ks[7], (DEPTH, POOL_GROUPS, POOL_GROUP_DIM, POOL_GROUP_DIM), POOL_GROUP_DIM ** -0.5),
        "pool_scale": gain(ks[8], (DEPTH, POOL_WIDTH)),
        "diff_lambda": nrm(ks[9], (DEPTH, 4, HEAD_DIM), 0.1),
        "diff_subln": gain(ks[10], (DEPTH, DIFF_V_DIM)),
        "ffn2_norm": gain(ks[11], (DEPTH, D_MODEL)),
        "ffn2_w_in": nrm(ks[12], (DEPTH, D_MODEL, 2 * D_FF), D_MODEL ** -0.5),
        "ffn2_w_out": nrm(ks[13], (DEPTH, D_FF, D_MODEL), D_FF ** -0.5),
        "final_norm": gain(ks[14], (D_MODEL,)),
    }


def reference(x, ffn1_norm, ffn1_w_in, ffn1_w_out, mix_norm, mix_w_in, mix_w_out, pool_w, pool_scale,
              diff_lambda, diff_subln, ffn2_norm, ffn2_w_in, ffn2_w_out, final_norm):
    cos, sin = rope_tables(x.shape[1])
    for l in range(DEPTH):
        lambda_init = 0.8 - 0.6 * math.exp(-0.3 * l)
        x = x + 0.5 * swiglu_ffn(rmsnorm(x, ffn1_norm[l]), ffn1_w_in[l], ffn1_w_out[l])
        x = x + token_mixing(rmsnorm(x, mix_norm[l]), mix_w_in[l], mix_w_out[l], pool_w[l], pool_scale[l],
                             diff_lambda[l], diff_subln[l], lambda_init, cos, sin)
        x = x + 0.5 * swiglu_ffn(rmsnorm(x, ffn2_norm[l]), ffn2_w_in[l], ffn2_w_out[l])
    return rmsnorm(x, final_norm)
```

```cpp
#include <hip/hip_runtime.h>
#include <hip/hip_cooperative_groups.h>
#include <cstdio>
#include <cstdint>
#include <cmath>
namespace cg = cooperative_groups;
namespace pg8 {
#define PG8_LAS __attribute__((address_space(3)))
typedef unsigned short bf16_t;
typedef short bf16x8 __attribute__((ext_vector_type(8)));
typedef float f32x4 __attribute__((ext_vector_type(4)));
typedef unsigned u32x4 __attribute__((ext_vector_type(4)));
constexpr int BM = 256, BK = 64, HALF = 128, HTB = HALF * BK * 2  , STAGE_BYTES = 8 * HTB, NXCD = 8, WGM = 8;

__host__ __device__ __forceinline__ int lds_byte(int r, int c) { const int st = (r >> 4) * 2 + (c >> 5), rr = r & 15, cc = c & 31, ob = rr * 64 + cc * 2; return st * 1024 + (ob ^ (((ob >> 9) & 1) << 5)); }
__host__ __device__ __forceinline__ void stage_rc(int b, int& R, int& C) { const int st = b / 1024, sb = b % 1024, swz = sb ^ (((sb >> 9) & 1) << 5); R = (st >> 1) * 16 + swz / 64; C = (st & 1) * 32 + (swz % 64) / 2; }
__host__ __device__ __forceinline__ int perm32(int rho) { const int n = rho >> 4, i = rho & 15; return 8 * (i >> 2) + 4 * n + (i & 3); }

struct Unit { int pm, pn, idx; };
struct Gemm { const bf16_t* A; const bf16_t* Bt; int M, N, K; };

struct StaticOrder {
    int nM, nN, nwg, G, c;
    __host__ __device__ void init(int M, int N, int G_, int c_) { nM = M / BM; nN = N / BM; nwg = nM * nN; G = G_; c = c_; }
    __host__ __device__ bool next(int i, Unit& u) const {
        const long L = (long)i * G + c; if (L >= nwg) return false;
        int wgid = (int)L; { const int q = nwg / NXCD, r = nwg % NXCD, xcd = wgid % NXCD, off = wgid / NXCD; wgid = (xcd < r ? xcd * (q + 1) : r * (q + 1) + (xcd - r) * q) + off; }
        const int nig = WGM * nN, gid = wgid / nig, fm = gid * WGM, gsz = (nM - fm) < WGM ? (nM - fm) : WGM;
        u.pm = fm + ((wgid % nig) % gsz); u.pn = (wgid % nig) / gsz; u.idx = i; return true;
    }
    __device__ __forceinline__ void a_ready(const Unit&) const {}
    __device__ __forceinline__ void done(const Unit&) const {}
};

__device__ __forceinline__ unsigned cvt_pk_bf16(float lo, float hi) { unsigned r; asm volatile("v_cvt_pk_bf16_f32 %0, %1, %2" : "=v"(r) : "v"(lo), "v"(hi)); return r; }
typedef float f32x2 __attribute__((ext_vector_type(2)));
template <class Epi, class Sched, bool ALIGN_EPI = false, bool SP2 = false>
__device__ __forceinline__ void gemm_phase(PG8_LAS unsigned char* lds, const Gemm g, const Sched& S, const Epi& E) {
    int tid_ = threadIdx.x; asm volatile("" : "+v"(tid_));
    const int tid = tid_, wid = __builtin_amdgcn_readfirstlane(tid >> 6), lane = tid & 63, wr = wid >> 2, wc = wid & 3, fr = lane & 15, fq = lane >> 4;
    const int K = g.K, nt = K / BK;
    unsigned voffA[2], voffB[2];
#pragma unroll
    for (int i = 0; i < 2; ++i) { int R, C; stage_rc(tid * 16 + i * 8192, R, C); const int Rb = Epi::PERM ? ((R & ~31) + perm32(R & 31)) : R;
        voffA[i] = (unsigned)(R * K + C) * 2u; voffB[i] = (unsigned)(Rb * K + C) * 2u; }
    const size_t kstep = (size_t)(BK * 2);
    const size_t hstep = (size_t)HALF * K * 2;
    const size_t tstep = 2 * hstep;
    const unsigned ldsw = (unsigned)wid * 1024u;
    const int aoff = lds_byte(wr * 64 + fr, fq * 8), boff = lds_byte(wc * 32 + fr, fq * 8);
#define PG8_SA(b, h) (((b) * 2 + (h)) * HTB)
#define PG8_SB(b, h) ((4 + (b) * 2 + (h)) * HTB)
#define PG8_STAGE(bufoff, gbase, voff) do { _Pragma("unroll") for (int _i = 0; _i < 2; ++_i) \
        __builtin_amdgcn_global_load_lds((const unsigned*)((const char*)(gbase) + (voff)[_i]), (PG8_LAS unsigned*)(lds + (bufoff) + ldsw + _i * 8192), 16, 0, 0); } while (0)
#define PG8_LDA(dst, b, h) do { _Pragma("unroll") for (int m = 0; m < 4; ++m) _Pragma("unroll") for (int k = 0; k < 2; ++k) dst[m][k] = *(const PG8_LAS bf16x8*)(lds + PG8_SA(b, h) + aoff + m * 2048 + k * 1024); } while (0)
#define PG8_LDB(dst, b, h) do { _Pragma("unroll") for (int n = 0; n < 2; ++n) _Pragma("unroll") for (int k = 0; k < 2; ++k) dst[n][k] = *(const PG8_LAS bf16x8*)(lds + PG8_SB(b, h) + boff + n * 2048 + k * 1024); } while (0)
#define PG8_MMA(ai, bj, At, Bt) do { __builtin_amdgcn_s_setprio(1); _Pragma("unroll") for (int m = 0; m < 4; ++m) _Pragma("unroll") for (int n = 0; n < 2; ++n) _Pragma("unroll") for (int k = 0; k < 2; ++k) \
        acc[ai][bj][m][n] = __builtin_amdgcn_mfma_f32_16x16x32_bf16(Bt[n][k], At[m][k], acc[ai][bj][m][n], 0, 0, 0); __builtin_amdgcn_s_setprio(0); } while (0)
#define PG8_WAIT_V(n) asm volatile("s_waitcnt vmcnt(" #n ")" ::: "memory")
#define PG8_WAIT_L(n) asm volatile("s_waitcnt lgkmcnt(" #n ")" ::: "memory")
#define PG8_BAR __builtin_amdgcn_s_barrier()
#define PG8_SCHED __builtin_amdgcn_sched_barrier(0)
    Unit cur, nxt; int ui = 0;
    if (!S.next(0, cur)) return;
    f32x4 acc[2][2][4][2];
#pragma unroll
    for (int a = 0; a < 2; ++a)
#pragma unroll
        for (int b = 0; b < 2; ++b)
#pragma unroll
            for (int m = 0; m < 4; ++m)
#pragma unroll
                for (int n = 0; n < 2; ++n) acc[a][b][m][n] = (f32x4){0.f, 0.f, 0.f, 0.f};
    bf16x8 At[4][2], B0[2][2], B1[2][2];
    const char* cA = (const char*)g.A + (size_t)cur.pm * tstep; const char* cB = (const char*)g.Bt + (size_t)cur.pn * tstep;
    S.a_ready(cur);
    if constexpr (SP2) {
        PG8_STAGE(PG8_SB(0, 0), cB, voffB); PG8_STAGE(PG8_SB(0, 1), cB + hstep, voffB); PG8_STAGE(PG8_SA(0, 0), cA, voffA); PG8_STAGE(PG8_SA(0, 1), cA + hstep, voffA);
        if (wr == 1) PG8_BAR;
        PG8_WAIT_V(2); PG8_BAR;
        PG8_STAGE(PG8_SB(1, 0), cB + kstep, voffB); PG8_STAGE(PG8_SA(1, 0), cA + kstep, voffA); PG8_STAGE(PG8_SB(1, 1), cB + hstep + kstep, voffB);
        PG8_WAIT_V(6); PG8_BAR;
    } else {
        PG8_STAGE(PG8_SB(0, 0), cB, voffB); PG8_STAGE(PG8_SA(0, 0), cA, voffA); PG8_STAGE(PG8_SB(0, 1), cB + hstep, voffB); PG8_STAGE(PG8_SA(0, 1), cA + hstep, voffA);
        if (wr == 1) PG8_BAR;
        PG8_WAIT_V(4); PG8_BAR;
        PG8_STAGE(PG8_SB(1, 0), cB + kstep, voffB); PG8_STAGE(PG8_SA(1, 0), cA + kstep, voffA); PG8_STAGE(PG8_SB(1, 1), cB + hstep + kstep, voffB);
        PG8_WAIT_V(6); PG8_BAR;
    }
    for (;;) {
        const bool has_next = S.next(ui + 1, nxt);
        const char* nA = has_next ? (const char*)g.A + (size_t)nxt.pm * tstep : cA; const char* nB = has_next ? (const char*)g.Bt + (size_t)nxt.pn * tstep : cB;
        for (int t = 0; t < nt; t += 2) {
            const bool last = (t == nt - 2);
            const char* a1 = cA + (size_t)(t + 1) * kstep;
            const char* a2 = last ? nA : cA + (size_t)(t + 2) * kstep; const char* b2 = last ? nB : cB + (size_t)(t + 2) * kstep;
            const char* a3 = a2 + kstep; const char* b3 = b2 + kstep;
            if (last && has_next) S.a_ready(nxt);
            if constexpr (SP2) {
            PG8_LDB(B0, 0, 0); PG8_LDB(B1, 0, 1); PG8_SCHED; PG8_LDA(At, 0, 0); PG8_STAGE(PG8_SA(1, 1), a1 + hstep, voffA);
            PG8_WAIT_V(8); PG8_WAIT_L(0); PG8_BAR; PG8_MMA(0, 0, At, B0); PG8_MMA(0, 1, At, B1); PG8_BAR; PG8_SCHED;
            PG8_LDA(At, 0, 1); PG8_STAGE(PG8_SB(0, 0), b2, voffB); PG8_STAGE(PG8_SB(0, 1), b2 + hstep, voffB); PG8_STAGE(PG8_SA(0, 0), a2, voffA);
            PG8_WAIT_V(8); PG8_WAIT_L(0); PG8_BAR; PG8_MMA(1, 0, At, B0); PG8_MMA(1, 1, At, B1); PG8_BAR; PG8_SCHED;
            PG8_LDB(B0, 1, 0); PG8_LDB(B1, 1, 1); PG8_SCHED; PG8_LDA(At, 1, 0); PG8_STAGE(PG8_SA(0, 1), a2 + hstep, voffA);
            PG8_WAIT_V(8); PG8_WAIT_L(0); PG8_BAR; PG8_MMA(0, 0, At, B0); PG8_MMA(0, 1, At, B1); PG8_BAR; PG8_SCHED;
            PG8_LDA(At, 1, 1); PG8_STAGE(PG8_SB(1, 0), b3, voffB); PG8_STAGE(PG8_SB(1, 1), b3 + hstep, voffB); PG8_STAGE(PG8_SA(1, 0), a3, voffA);
            PG8_WAIT_V(8); PG8_WAIT_L(0); PG8_BAR; PG8_MMA(1, 0, At, B0); PG8_MMA(1, 1, At, B1); PG8_BAR; PG8_SCHED;
            } else {
            PG8_LDB(B0, 0, 0); PG8_SCHED; PG8_LDA(At, 0, 0); PG8_STAGE(PG8_SA(1, 1), a1 + hstep, voffA);
            PG8_WAIT_L(8); PG8_BAR; PG8_WAIT_L(0); PG8_MMA(0, 0, At, B0); PG8_BAR; PG8_SCHED;
            PG8_LDB(B1, 0, 1); PG8_STAGE(PG8_SB(0, 0), b2, voffB);
            PG8_BAR; PG8_WAIT_L(0); PG8_MMA(0, 1, At, B1); PG8_BAR;
            PG8_LDA(At, 0, 1); PG8_STAGE(PG8_SA(0, 0), a2, voffA);
            PG8_BAR; PG8_WAIT_L(0); PG8_MMA(1, 0, At, B0); PG8_BAR; PG8_SCHED;
            PG8_STAGE(PG8_SB(0, 1), b2 + hstep, voffB);
            PG8_WAIT_V(6); PG8_BAR; PG8_MMA(1, 1, At, B1); PG8_BAR;
            PG8_LDB(B0, 1, 0); PG8_SCHED; PG8_LDA(At, 1, 0); PG8_STAGE(PG8_SA(0, 1), a2 + hstep, voffA);
            PG8_WAIT_L(8); PG8_BAR; PG8_WAIT_L(0); PG8_MMA(0, 0, At, B0); PG8_BAR; PG8_SCHED;
            PG8_LDB(B1, 1, 1); PG8_STAGE(PG8_SB(1, 0), b3, voffB);
            PG8_BAR; PG8_WAIT_L(0); PG8_MMA(0, 1, At, B1); PG8_BAR;
            PG8_LDA(At, 1, 1); PG8_STAGE(PG8_SA(1, 0), a3, voffA);
            PG8_BAR; PG8_WAIT_L(0); PG8_MMA(1, 0, At, B0); PG8_BAR; PG8_SCHED;
            PG8_STAGE(PG8_SB(1, 1), b3 + hstep, voffB);
            PG8_WAIT_V(6); PG8_BAR; PG8_MMA(1, 1, At, B1); PG8_BAR;
            }
        }
        if constexpr (ALIGN_EPI) { if (wr == 0) PG8_BAR; }
        if constexpr (!Epi::AFTER_DRAIN) { E(acc, cur, wr, wc, fr, fq); S.done(cur); }
        if (!has_next) break;
#pragma unroll
        for (int a = 0; a < 2; ++a)
#pragma unroll
            for (int b = 0; b < 2; ++b)
#pragma unroll
                for (int m = 0; m < 4; ++m)
#pragma unroll
                    for (int n = 0; n < 2; ++n) acc[a][b][m][n] = (f32x4){0.f, 0.f, 0.f, 0.f};
        cur = nxt; cA = nA; cB = nB; ++ui;
        if constexpr (ALIGN_EPI) { if (wr == 1) PG8_BAR; }
    }
    PG8_WAIT_V(0);
    if constexpr (!ALIGN_EPI) { if (wr == 0) PG8_BAR; }
    PG8_BAR;
    if constexpr (Epi::AFTER_DRAIN) { E.fused(acc, cur, wr, wc, fr, fq, lds, wid, lane); S.done(cur); }
#undef PG8_SA
#undef PG8_SB
#undef PG8_STAGE
#undef PG8_LDA
#undef PG8_LDB
#undef PG8_MMA
#undef PG8_WAIT_V
#undef PG8_WAIT_L
#undef PG8_BAR
#undef PG8_SCHED
}
}

#ifndef PG8_SP2
#define PG8_SP2 true
#endif
#ifndef PG8_ALIGN
#define PG8_ALIGN true
#endif
#define LAS __attribute__((address_space(3)))
typedef unsigned short bf16_t;
typedef short bf16x8 __attribute__((ext_vector_type(8)));
typedef float f32x4 __attribute__((ext_vector_type(4)));
typedef float f32x16 __attribute__((ext_vector_type(16)));
typedef unsigned u32x4 __attribute__((ext_vector_type(4)));
typedef unsigned u32x2 __attribute__((ext_vector_type(2)));
constexpr int BATCH = 16, SEQ = 2048, DM = 1024, DEPTH = 2, MTOK = BATCH * SEQ, DFF = 2816, NQK = 2048, NVC = 512;
constexpr float NORM_EPS = 1e-6f;
constexpr float QSCALE = 0.125f * 1.4426950408889634f;
constexpr size_t MiB = 1u << 20;
constexpr size_t WS_SSQ16 = 372 * MiB, WS_TOTAL = 388 * MiB;
constexpr size_t WS_SSQ = 0, WS_KMEAN = 1 * MiB, ZERO_FLOATS = (1 * MiB + 2 * 128 * 256 * 4) / 4;
constexpr size_t WS_COS = 2 * MiB, WS_SIN = 2 * MiB + 256 * 1024;
constexpr size_t WS_W = 4 * MiB, W_LAYER = 40 * MiB;
constexpr size_t WO_W1A = 0, WO_W2A = 11 * MiB, WO_WQK = 16 * MiB + 512 * 1024, WO_WV = 20 * MiB + 512 * 1024, WO_WO = 21 * MiB + 512 * 1024, WO_W1B = 23 * MiB + 512 * 1024, WO_W2B = 34 * MiB + 512 * 1024;
constexpr size_t WS_XB = 84 * MiB, WS_H = 148 * MiB;
constexpr size_t WS_U = 148 * MiB, WS_DQ = 164 * MiB, WS_DK = 196 * MiB, WS_MQ = 228 * MiB, WS_MK = 244 * MiB, WS_VT = 260 * MiB, WS_MV = 292 * MiB, WS_Y = 308 * MiB, WS_END = 372 * MiB;
constexpr int LDS_BYTES = 147456;

using pg8::cvt_pk_bf16;
__device__ __forceinline__ float bf2f(bf16_t v) { return __uint_as_float((unsigned)v << 16); }
__device__ __forceinline__ float wave_sum(float v) {
#pragma unroll
    for (int o = 1; o < 64; o <<= 1) v += __shfl_xor(v, o);
    return v;
}
#define LDS_WAIT() asm volatile("s_waitcnt lgkmcnt(0)" ::: "memory")

__device__ __forceinline__ float row_ssq(const float* part, int row) {
    const f32x4* p = (const f32x4*)(part + (size_t)row * 16); const f32x4 a = p[0], b = p[1], c = p[2], d = p[3];
    return (((a[0] + a[1]) + (a[2] + a[3])) + ((b[0] + b[1]) + (b[2] + b[3]))) + (((c[0] + c[1]) + (c[2] + c[3])) + ((d[0] + d[1]) + (d[2] + d[3])));
}
__device__ __forceinline__ float row_rstd(const float* part, int row) { return __builtin_amdgcn_rsqf(row_ssq(part, row) * (1.0f / DM) + NORM_EPS); }
constexpr int RSTD_TAB_OFF = 131072, RSTD_TAB_UNITS = 14;
template <bool BYPN> __device__ __forceinline__ void build_rstd_tab(LAS float* tab, const float* part, const pg8::StaticOrder& S) {
    int tid_ = threadIdx.x; asm volatile("" : "+v"(tid_)); const int row = tid_ >> 1, hf = tid_ & 1;
    pg8::Unit u; int prev_base = -1;
    for (int i = 0; i < RSTD_TAB_UNITS && S.next(i, u); ++i) {
        const int base = (BYPN ? u.pn : u.pm) * 256;
        if (base == prev_base) {
            if (hf == 0) tab[i * 256 + row] = tab[(i - 1) * 256 + row];
            continue;
        }
        prev_base = base;
        const f32x4* p = (const f32x4*)(part + (size_t)(base + row) * 16 + hf * 8); const f32x4 a = p[0], b = p[1];
        const float s = ((a[0] + a[1]) + (a[2] + a[3])) + ((b[0] + b[1]) + (b[2] + b[3])); const float o = __shfl_xor(s, 1);
        const float tot = hf ? (o + s) : (s + o);
        if (hf == 0) tab[i * 256 + row] = __builtin_amdgcn_rsqf(tot * (1.0f / DM) + NORM_EPS);
    }
}
struct EpiSwiglu {
    static constexpr bool PERM = true, AFTER_DRAIN = false;
    bf16_t* H; const LAS float* tab;
    __device__ __forceinline__ void operator()(const f32x4 (&acc)[2][2][4][2], const pg8::Unit& u, int wr, int wc, int fr_, int fq_) const {
        int tl_ = threadIdx.x; asm volatile("" : "+v"(tl_)); const int fr = tl_ & 15, fq = (tl_ >> 4) & 3; (void)fr_; (void)fq_;
        const int row0 = u.pm * 256 + wr * 64 + fr, colh = u.pn * 128 + wc * 32 + 8 * fq;
#pragma unroll
        for (int ai = 0; ai < 2; ++ai)
#pragma unroll
            for (int m = 0; m < 4; ++m) {
                const int row = row0 + ai * 128 + m * 16;
                const float rs = tab[u.idx * 256 + wr * 64 + fr + ai * 128 + m * 16];
                const f32x4 a0 = acc[ai][0][m][0], a1 = acc[ai][0][m][1], b0 = acc[ai][1][m][0], b1 = acc[ai][1][m][1];
                const float nrs = rs * -1.4426950408889634f, rs2 = rs * rs;
                const f32x4 t0 = a0 * nrs, t1 = a1 * nrs;
                f32x4 e0, e1, r0, r1;
#pragma unroll
                for (int j = 0; j < 4; ++j) { e0[j] = __builtin_amdgcn_exp2f(t0[j]); e1[j] = __builtin_amdgcn_exp2f(t1[j]); }
                const f32x4 d0 = e0 + 1.0f, d1 = e1 + 1.0f;
#pragma unroll
                for (int j = 0; j < 4; ++j) { r0[j] = __builtin_amdgcn_rcpf(d0[j]); r1[j] = __builtin_amdgcn_rcpf(d1[j]); }
                const f32x4 h0 = (a0 * b0) * (r0 * rs2), h1 = (a1 * b1) * (r1 * rs2);
                u32x4 w; w.x = cvt_pk_bf16(h0[0], h0[1]); w.y = cvt_pk_bf16(h0[2], h0[3]); w.z = cvt_pk_bf16(h1[0], h1[1]); w.w = cvt_pk_bf16(h1[2], h1[3]);
                *(u32x4*)(H + (size_t)row * DFF + colh) = w;
                if (m == 3) asm volatile("" ::: "memory");
            }
    }
};
struct EpiResid {
    static constexpr bool PERM = true, AFTER_DRAIN = false;
    bf16_t* xb; float* ssq_out; float alpha;
    __device__ __forceinline__ void operator()(const f32x4 (&acc)[2][2][4][2], const pg8::Unit& u, int wr, int wc, int fr_, int fq_) const {
        int tl_ = threadIdx.x; asm volatile("" : "+v"(tl_)); const int fr = tl_ & 15, fq = (tl_ >> 4) & 3; (void)fr_; (void)fq_;
        const int row0 = u.pm * 256 + wr * 64 + fr, col0 = u.pn * 256 + wc * 32 + 8 * fq;
#pragma unroll
        for (int ai = 0; ai < 2; ++ai)
#pragma unroll
            for (int m = 0; m < 4; ++m) {
                const int row = row0 + ai * 128 + m * 16; const size_t off = (size_t)row * DM + col0; float s = 0.f;
#pragma unroll
                for (int bj = 0; bj < 2; ++bj) {
                    const u32x4 xo = *(const u32x4*)(xb + off + bj * 128);
                    f32x4 v0, v1;
                    v0[0] = __uint_as_float(xo.x << 16); v0[1] = __uint_as_float(xo.x & 0xffff0000u); v0[2] = __uint_as_float(xo.y << 16); v0[3] = __uint_as_float(xo.y & 0xffff0000u);
                    v1[0] = __uint_as_float(xo.z << 16); v1[1] = __uint_as_float(xo.z & 0xffff0000u); v1[2] = __uint_as_float(xo.w << 16); v1[3] = __uint_as_float(xo.w & 0xffff0000u);
                    v0 = v0 + acc[ai][bj][m][0] * alpha; v1 = v1 + acc[ai][bj][m][1] * alpha;
                    u32x4 w; w.x = cvt_pk_bf16(v0[0], v0[1]); w.y = cvt_pk_bf16(v0[2], v0[3]); w.z = cvt_pk_bf16(v1[0], v1[1]); w.w = cvt_pk_bf16(v1[2], v1[3]);
                    *(u32x4*)(xb + off + bj * 128) = w;
                    s += (v0[0] * v0[0] + v0[1] * v0[1]) + (v0[2] * v0[2] + v0[3] * v0[3]) + (v1[0] * v1[0] + v1[1] * v1[1]) + (v1[2] * v1[2] + v1[3] * v1[3]);
                }
                s += __shfl_xor(s, 16); s += __shfl_xor(s, 32);
                if (fq == 0) ssq_out[(size_t)row * 16 + u.pn * 4 + wc] = s;
            }
    }
};
struct EpiQK {
    static constexpr bool PERM = true, AFTER_DRAIN = false;
    bf16_t *U, *DQ, *DK, *MQ, *MK, *MV; const LAS float* tab; const float* cosT; const float* sinT; float* kmean;
    __device__ __forceinline__ void operator()(const f32x4 (&acc)[2][2][4][2], const pg8::Unit& u, int wr, int wc, int fr_, int fq_) const {
        int tl_ = threadIdx.x; asm volatile("" : "+v"(tl_)); const int fr = tl_ & 15, fq = (tl_ >> 4) & 3; (void)fr_; (void)fq_;
        const int pn = u.pn, row0 = u.pm * 256 + wr * 64 + fr, cw = wc * 32 + 8 * fq;
        if (pn == 0 || pn == 7) {
            bf16_t* Ud = pn == 0 ? U : MV;
#pragma unroll
            for (int ai = 0; ai < 2; ++ai)
#pragma unroll
                for (int m = 0; m < 4; ++m) {
                    const int row = row0 + ai * 128 + m * 16; const float rs = tab[u.idx * 256 + wr * 64 + fr + ai * 128 + m * 16];
#pragma unroll
                    for (int bj = 0; bj < 2; ++bj) {
                        const f32x4 v0 = acc[ai][bj][m][0] * rs, v1 = acc[ai][bj][m][1] * rs;
                        u32x4 w; w.x = cvt_pk_bf16(v0[0], v0[1]); w.y = cvt_pk_bf16(v0[2], v0[3]); w.z = cvt_pk_bf16(v1[0], v1[1]); w.w = cvt_pk_bf16(v1[2], v1[3]);
                        *(u32x4*)(Ud + (size_t)row * 256 + bj * 128 + cw) = w;
                    }
                    if (m == 3) asm volatile("" ::: "memory");
                }
            return;
        }
        bf16_t* base; int pitch; float qs = 1.0f;
        if (pn <= 2) { base = DQ + (pn - 1) * 256; pitch = 512; qs = QSCALE; }
        else if (pn <= 4) { base = DK + (pn - 3) * 256; pitch = 512; }
        else if (pn == 5) { base = MQ; pitch = 256; qs = QSCALE; }
        else { base = MK; pitch = 256; }
        const int i0 = 16 * (wc & 1) + 4 * fq;
        f32x4 cs[2][2];
#pragma unroll
        for (int bj = 0; bj < 2; ++bj) { cs[bj][0] = (f32x4){0.f, 0.f, 0.f, 0.f}; cs[bj][1] = (f32x4){0.f, 0.f, 0.f, 0.f}; }
#pragma unroll
        for (int ai = 0; ai < 2; ++ai)
#pragma unroll
            for (int m = 0; m < 4; ++m) {
                const int row = row0 + ai * 128 + m * 16, pos = row & (SEQ - 1);
                const float rs = qs * tab[u.idx * 256 + wr * 64 + fr + ai * 128 + m * 16];
                const f32x4 c4 = *(const f32x4*)(cosT + pos * 32 + i0), s4 = *(const f32x4*)(sinT + pos * 32 + i0);
#pragma unroll
                for (int bj = 0; bj < 2; ++bj) {
                    const f32x4 x1 = acc[ai][bj][m][0] * rs, x2 = acc[ai][bj][m][1] * rs;
                    const f32x4 o1 = x1 * c4 - x2 * s4, o2 = x2 * c4 + x1 * s4;
                    u32x4 w; w.x = cvt_pk_bf16(o1[0], o1[1]); w.y = cvt_pk_bf16(o1[2], o1[3]); w.z = cvt_pk_bf16(o2[0], o2[1]); w.w = cvt_pk_bf16(o2[2], o2[3]);
                    *(u32x4*)(base + (size_t)row * pitch + bj * 128 + cw) = w;
                    cs[bj][0] += o1; cs[bj][1] += o2;
                }
                asm volatile("" : "+v"(cs[0][0]), "+v"(cs[0][1]), "+v"(cs[1][0]), "+v"(cs[1][1]));
                if (m == 3) asm volatile("" ::: "memory");
            }
        if (pn == 6) {
#pragma unroll
            for (int bj = 0; bj < 2; ++bj)
#pragma unroll
                for (int n = 0; n < 2; ++n)
#pragma unroll
                    for (int j = 0; j < 4; ++j) {
                        float v = cs[bj][n][j];
                        v += __shfl_xor(v, 1); v += __shfl_xor(v, 2); v += __shfl_xor(v, 4); v += __shfl_xor(v, 8);
                        if (fr == 0) unsafeAtomicAdd(kmean + (size_t)u.pm * 256 + bj * 128 + cw + 4 * n + j, v);
                    }
        }
    }
};
struct EpiVt {
    static constexpr bool PERM = true, AFTER_DRAIN = false;
    bf16_t* Vt; const LAS float* tab;
    __device__ __forceinline__ void operator()(const f32x4 (&acc)[2][2][4][2], const pg8::Unit& u, int wr, int wc, int fr_, int fq_) const {
        int tl_ = threadIdx.x; asm volatile("" : "+v"(tl_)); const int fr = tl_ & 15, fq = (tl_ >> 4) & 3; (void)fr_; (void)fq_;
        const int ch0 = u.pm * 256 + wr * 64 + fr, tok0 = u.pn * 256 + wc * 32 + 8 * fq;
        f32x4 rs[2][2];
#pragma unroll
        for (int bj = 0; bj < 2; ++bj)
#pragma unroll
            for (int n = 0; n < 2; ++n) {
                rs[bj][n] = *(const LAS f32x4*)(tab + u.idx * 256 + bj * 128 + wc * 32 + 8 * fq + 4 * n);
            }
#pragma unroll
        for (int ai = 0; ai < 2; ++ai)
#pragma unroll
            for (int m = 0; m < 4; ++m) {
                const int ch = ch0 + ai * 128 + m * 16;
#pragma unroll
                for (int bj = 0; bj < 2; ++bj) {
                    const f32x4 v0 = acc[ai][bj][m][0] * rs[bj][0], v1 = acc[ai][bj][m][1] * rs[bj][1];
                    u32x4 w; w.x = cvt_pk_bf16(v0[0], v0[1]); w.y = cvt_pk_bf16(v0[2], v0[3]); w.z = cvt_pk_bf16(v1[0], v1[1]); w.w = cvt_pk_bf16(v1[2], v1[3]);
                    *(u32x4*)(Vt + (size_t)ch * MTOK + tok0 + bj * 128) = w;
                }
                if (m == 3) asm volatile("" ::: "memory");
            }
    }
};

__device__ __forceinline__ int permute64(int col) { const int base = col & ~63, d = col & 63; return base + 32 * ((d >> 4) & 1) + 8 * ((d >> 2) & 3) + 4 * (d >> 5) + (d & 3); }
__device__ __forceinline__ bf16_t* dst_row(int kind, int col, bf16_t* d0, bf16_t* d1, int K) {
    if (kind == 0) return d0 + (size_t)col * K;
    if (kind == 1) { const int half = col >= DFF ? 1 : 0, c2 = col - half * DFF; return d0 + (size_t)(256 * (c2 >> 7) + 128 * half + (c2 & 127)) * K; }
    if (col < 256) return d0 + (size_t)col * K;
    if (col < 1280) return d0 + (size_t)permute64(col) * K;
    if (col < 1792) return d1 + (size_t)(col - 1280) * K;
    if (col < 2304) return d0 + (size_t)(permute64(col) - 512) * K;
    return d0 + (size_t)(1792 + col - 2304) * K;
}
__device__ __forceinline__ void transpose_item(const float* __restrict__ W, int K, int N, const float* __restrict__ gain, int kind, bf16_t* d0, bf16_t* d1, LAS float* scr, int item, int lane) {
    const int nblk = N / 64, kb = item / nblk, nb = item % nblk, k0 = 64 * kb, n0 = 64 * nb;
    f32x4 v[16];
#pragma unroll
    for (int i = 0; i < 16; ++i) v[i] = *(const f32x4*)(W + (size_t)(k0 + 4 * i + (lane >> 4)) * N + n0 + 4 * (lane & 15));
#pragma unroll
    for (int i = 0; i < 16; ++i) { const int kk = 4 * i + (lane >> 4); const float g = gain ? gain[k0 + kk] : 1.0f; LAS float* sp = scr + kk * 65 + 4 * (lane & 15);
        sp[0] = v[i][0] * g; sp[1] = v[i][1] * g; sp[2] = v[i][2] * g; sp[3] = v[i][3] * g; }
    LDS_WAIT(); asm volatile("" ::: "memory");
    const int c = lane & 7;
#pragma unroll
    for (int j = 0; j < 8; ++j) { const int n = (lane >> 3) + 8 * j; const LAS float* sq = scr + (8 * c) * 65 + n;
        u32x4 o; o.x = cvt_pk_bf16(sq[0 * 65], sq[1 * 65]); o.y = cvt_pk_bf16(sq[2 * 65], sq[3 * 65]); o.z = cvt_pk_bf16(sq[4 * 65], sq[5 * 65]); o.w = cvt_pk_bf16(sq[6 * 65], sq[7 * 65]);
        *(u32x4*)(dst_row(kind, n0 + n, d0, d1, K) + k0 + 8 * c) = o; }
    LDS_WAIT(); asm volatile("" ::: "memory");
}

__device__ __forceinline__ int crow(int r, int hi) { return (r & 3) + 8 * (r >> 2) + 4 * hi; }
template <int KSTR> __device__ __forceinline__ void qk_tile(f32x16& p0, f32x16& p1, const LAS unsigned char* Kl, const bf16x8 (&qf)[4], int q, int hi) {
    const f32x16 z = {0.f, 0.f, 0.f, 0.f, 0.f, 0.f, 0.f, 0.f, 0.f, 0.f, 0.f, 0.f, 0.f, 0.f, 0.f, 0.f};
    __builtin_amdgcn_s_setprio(1);
#pragma unroll
    for (int s = 0; s < 4; ++s) {
        const bf16x8 a0 = *(const LAS bf16x8*)(Kl + q * KSTR + s * 32 + hi * 16);
        const bf16x8 a1 = *(const LAS bf16x8*)(Kl + (32 + q) * KSTR + s * 32 + hi * 16);
        p0 = __builtin_amdgcn_mfma_f32_32x32x16_bf16(a0, qf[s], s == 0 ? z : p0, 0, 0, 0);
        p1 = __builtin_amdgcn_mfma_f32_32x32x16_bf16(a1, qf[s], s == 0 ? z : p1, 0, 0, 0);
    }
    __builtin_amdgcn_s_setprio(0);
}
template <int NDV> __device__ __forceinline__ void softmax_step(f32x16& p0, f32x16& p1, float& m_run, float& l_run, f32x16 (&o)[NDV]) {
    float mx = fmaxf(p0[0], p1[0]);
#pragma unroll
    for (int r = 1; r < 16; ++r) mx = fmaxf(mx, fmaxf(p0[r], p1[r]));
    { const auto rr = __builtin_amdgcn_permlane32_swap(__float_as_uint(mx), __float_as_uint(mx), false, false); mx = fmaxf(__uint_as_float(rr[0]), __uint_as_float(rr[1])); }
    if (__any(mx > m_run ? 1 : 0)) {
        const float m_new = fmaxf(m_run, mx);
        const float alpha = __builtin_amdgcn_exp2f(m_run - m_new);
        l_run *= alpha; m_run = m_new;
#pragma unroll
        for (int i = 0; i < NDV; ++i) o[i] = o[i] * alpha;
    }
    float rs = 0.f;
#pragma unroll
    for (int r = 0; r < 16; ++r) { p0[r] = __builtin_amdgcn_exp2f(p0[r] - m_run); p1[r] = __builtin_amdgcn_exp2f(p1[r] - m_run); rs += p0[r] + p1[r]; }
    l_run += rs;
}
__device__ __forceinline__ void pack_p(bf16x8 (&pk)[4], const f32x16& p0, const f32x16& p1) {
#pragma unroll
    for (int s = 0; s < 2; ++s) {
        u32x4 a, b;
        a.x = cvt_pk_bf16(p0[8 * s + 0], p0[8 * s + 1]); a.y = cvt_pk_bf16(p0[8 * s + 2], p0[8 * s + 3]); a.z = cvt_pk_bf16(p0[8 * s + 4], p0[8 * s + 5]); a.w = cvt_pk_bf16(p0[8 * s + 6], p0[8 * s + 7]);
        b.x = cvt_pk_bf16(p1[8 * s + 0], p1[8 * s + 1]); b.y = cvt_pk_bf16(p1[8 * s + 2], p1[8 * s + 3]); b.z = cvt_pk_bf16(p1[8 * s + 4], p1[8 * s + 5]); b.w = cvt_pk_bf16(p1[8 * s + 6], p1[8 * s + 7]);
        pk[s] = __builtin_bit_cast(bf16x8, a); pk[2 + s] = __builtin_bit_cast(bf16x8, b);
    }
}
template <int NDV> __device__ __forceinline__ void pv_tile(f32x16 (&o)[NDV], const LAS unsigned char* Vl, const bf16x8 (&pk)[4], int q, int hi) {
    __builtin_amdgcn_s_setprio(1);
#pragma unroll
    for (int blk = 0; blk < NDV; ++blk)
#pragma unroll
        for (int ks = 0; ks < 4; ++ks) {
            const bf16x8 va = *(const LAS bf16x8*)(Vl + (32 * blk + q) * 144 + ks * 32 + hi * 16);
            o[blk] = __builtin_amdgcn_mfma_f32_32x32x16_bf16(va, pk[ks], o[blk], 0, 0, 0);
        }
    __builtin_amdgcn_s_setprio(0);
}
__device__ __forceinline__ void vt_store(LAS unsigned char* Vl, int dv, int c, u32x4 v) {
    LAS unsigned char* p = Vl + dv * 144 + (c >> 1) * 32 + (c & 1) * 8;
    *(LAS u32x2*)p = (u32x2){v.x, v.y}; *(LAS u32x2*)(p + 16) = (u32x2){v.z, v.w};
}

template <int NDV, int KSTR, bool HASNEXT, bool DIAG>
__device__ __forceinline__ void attn_step(f32x16& p0, f32x16& p1, f32x16 (&o)[NDV], float& m_run, float& l_run, const bf16x8 (&qf)[4],
                                          const LAS unsigned char* Knext, const LAS unsigned char* Vcur, int q, int hi, int kbase, int qpos, bool allowed) {
    f32x16 n0, n1;
    if (HASNEXT) qk_tile<KSTR>(n0, n1, Knext, qf, q, hi);
    if (DIAG) {
#pragma unroll
        for (int r = 0; r < 16; ++r) { const int kk = kbase + crow(r, hi); if (kk > qpos) p0[r] = -INFINITY; if (kk + 32 > qpos) p1[r] = -INFINITY; }
    }
    float mx = fmaxf(p0[0], p1[0]);
#pragma unroll
    for (int r = 1; r < 16; ++r) mx = fmaxf(mx, fmaxf(p0[r], p1[r]));
    mx = fmaxf(mx, __shfl_xor(mx, 32));
    if (!allowed) mx = -INFINITY;
    if (__any(mx > m_run ? 1 : 0)) {
        const float m_new = fmaxf(m_run, mx);
        const float alpha = __builtin_amdgcn_exp2f(m_run - m_new);
        l_run *= alpha; m_run = m_new;
#pragma unroll
        for (int i = 0; i < NDV; ++i) o[i] = o[i] * alpha;
    }
    const float m_eff = allowed ? m_run : INFINITY;
    float rs = 0.f;
#pragma unroll
    for (int r = 0; r < 16; ++r) { p0[r] = __builtin_amdgcn_exp2f(p0[r] - m_eff); p1[r] = __builtin_amdgcn_exp2f(p1[r] - m_eff); rs += p0[r] + p1[r]; }
    l_run += rs;
    bf16x8 pk[4]; pack_p(pk, p0, p1);
    pv_tile<NDV>(o, Vcur, pk, q, hi);
    if (HASNEXT) { p0 = n0; p1 = n1; }
}

constexpr int DK_STR = 272, DK_BUF = 64 * DK_STR, DV_BUF = 128 * 144;
constexpr int D_LK = 0, D_LV = 2 * DK_BUF, D_STG = D_LV + 2 * DV_BUF;
__device__ __forceinline__ void diff_unit(int b, int h, int qi, const bf16_t* DQ, const bf16_t* DK, const bf16_t* Vt, bf16_t* Y, float lam, const float* subg, float lam_init, LAS unsigned char* lds) {
    int tid_ = threadIdx.x; asm volatile("" : "+v"(tid_)); const int tid = tid_, lane = tid & 63, q = lane & 31, hi = lane >> 5; const int wid = __builtin_amdgcn_readfirstlane(tid >> 6);
    const int rg = wid & 3, map = wid >> 2;
    const int q0 = qi * 128 + rg * 32, qpos = q0 + q;
    const size_t tokb = (size_t)b * SEQ;
    bf16x8 qf[4];
    { const bf16_t* qp = DQ + (tokb + qpos) * 512 + h * 128 + map * 64 + hi * 8;
#pragma unroll
      for (int s = 0; s < 4; ++s) qf[s] = *(const bf16x8*)(qp + 16 * s); }
    const int NT = 2 * qi + 2;
    const bf16_t* kg0 = DK + (tokb + (tid >> 4)) * 512 + h * 128 + (tid & 15) * 8;
    const bf16_t* vg0 = Vt + (size_t)(h * 128 + (tid >> 3)) * MTOK + tokb + (tid & 7) * 8;
    u32x4 ka0, ka1, va0, va1, kb0, kb1, vb0, vb1;
#define D_LOAD(S, t) do { k##S##0 = *(const u32x4*)(kg0 + (size_t)(t) * 64 * 512); k##S##1 = *(const u32x4*)(kg0 + (size_t)(t) * 64 * 512 + 32 * 512); \
                          v##S##0 = *(const u32x4*)(vg0 + (t) * 64); v##S##1 = *(const u32x4*)(vg0 + (size_t)64 * MTOK + (t) * 64); } while (0)
#define D_STORE(S, buf) do { *(LAS u32x4*)(lds + D_LK + (buf) * DK_BUF + (tid >> 4) * DK_STR + (tid & 15) * 16) = k##S##0; \
                             *(LAS u32x4*)(lds + D_LK + (buf) * DK_BUF + (32 + (tid >> 4)) * DK_STR + (tid & 15) * 16) = k##S##1; \
                             vt_store(lds + D_LV + (buf) * DV_BUF, tid >> 3, tid & 7, v##S##0); vt_store(lds + D_LV + (buf) * DV_BUF, 64 + (tid >> 3), tid & 7, v##S##1); } while (0)
#define ATT_BAR() asm volatile("s_waitcnt lgkmcnt(0)\n\ts_barrier" ::: "memory")
#define D_COMPUTE(t, cur) do { if (64 * (t) <= q0 + 31) { \
            f32x16 p0, p1; \
            qk_tile<DK_STR>(p0, p1, lds + D_LK + (cur) * DK_BUF + map * 128, qf, q, hi); \
            if (64 * (t) + 63 > q0) { \
                _Pragma("unroll") for (int r = 0; r < 16; ++r) { const int kk = 64 * (t) + crow(r, hi); if (kk > qpos) p0[r] = -INFINITY; if (kk + 32 > qpos) p1[r] = -INFINITY; } } \
            softmax_step<4>(p0, p1, m_run, l_run, o); \
            bf16x8 pk[4]; pack_p(pk, p0, p1); \
            pv_tile<4>(o, lds + D_LV + (cur) * DV_BUF, pk, q, hi); } } while (0)
    float m_run = -1e30f, l_run = 0.f;
    f32x16 o[4];
#pragma unroll
    for (int i = 0; i < 4; ++i)
#pragma unroll
        for (int r = 0; r < 16; ++r) o[i][r] = 0.f;
    D_LOAD(a, 0); D_LOAD(b, 1); D_STORE(a, 0); ATT_BAR();
    for (int t = 0; t < NT; t += 2) {
        { const int tl = (t + 2 < NT) ? t + 2 : NT - 1; D_LOAD(a, tl); }
        D_COMPUTE(t, 0);
        D_STORE(b, 1);
        ATT_BAR();
        { const int tl = (t + 3 < NT) ? t + 3 : NT - 1; D_LOAD(b, tl); }
        D_COMPUTE(t + 1, 1);
        if (t + 2 < NT) D_STORE(a, 0);
        ATT_BAR();
    }
#undef D_LOAD
#undef D_STORE
#undef D_COMPUTE
    const float l_tot = l_run + __shfl_xor(l_run, 32), inv = 1.0f / l_tot;
    LAS float* ex = (LAS float*)lds + rg * 4096;
    if (map == 1) {
#pragma unroll
        for (int i = 0; i < 4; ++i)
#pragma unroll
            for (int r = 0; r < 16; ++r) ex[(i * 16 + r) * 64 + lane] = o[i][r] * inv;
    }
    __syncthreads();
    if (map == 0) {
        float ss = 0.f;
#pragma unroll
        for (int i = 0; i < 4; ++i)
#pragma unroll
            for (int r = 0; r < 16; ++r) { const float v = o[i][r] * inv - lam * ex[(i * 16 + r) * 64 + lane]; o[i][r] = v; ss += v * v; }
        ss += __shfl_xor(ss, 32);
        const float rn = (1.0f - lam_init) / sqrtf(ss * (1.0f / 128.0f) + NORM_EPS);
        LAS unsigned char* stg = lds + D_STG + rg * 8704;
#pragma unroll
        for (int i = 0; i < 4; ++i)
#pragma unroll
            for (int r4 = 0; r4 < 4; ++r4) {
                const int dv = 32 * i + 8 * r4 + 4 * hi; const f32x4 g = *(const LAS f32x4*)((const LAS float*)(lds + RSTD_TAB_OFF) + dv);
                u32x2 w; w.x = cvt_pk_bf16(o[i][4 * r4 + 0] * rn * g[0], o[i][4 * r4 + 1] * rn * g[1]); w.y = cvt_pk_bf16(o[i][4 * r4 + 2] * rn * g[2], o[i][4 * r4 + 3] * rn * g[3]);
                *(LAS u32x2*)(stg + q * 272 + dv * 2) = w;
            }
        LDS_WAIT(); asm volatile("" ::: "memory");
        bf16_t* yo = Y + (tokb + q0) * DM + 256 + h * 128;
#pragma unroll
        for (int i = 0; i < 8; ++i) { const int id = i * 64 + lane, rw = id >> 4, c = id & 15;
            const u32x4 v = *(const LAS u32x4*)(stg + rw * 272 + c * 16); *(u32x4*)(yo + (size_t)rw * DM + c * 8) = v; }
    }
    __syncthreads();
}

constexpr int MK_BUF = 64 * 144, M_LK = 0, M_LV = 2 * MK_BUF, M_STG = 4 * MK_BUF;
__device__ __forceinline__ void moba_unit(int b, int h, int qb, const bf16_t* MQ, const bf16_t* MKp, const bf16_t* Vt, const float* kmean, bf16_t* Y, LAS unsigned char* lds) {
    int tid_ = threadIdx.x; asm volatile("" : "+v"(tid_)); const int tid = tid_, lane = tid & 63, q = lane & 31, hi = lane >> 5; const int wid = __builtin_amdgcn_readfirstlane(tid >> 6);
    const int q0 = qb * 256 + wid * 32, qpos = q0 + q;
    const size_t tokb = (size_t)b * SEQ;
    bf16x8 qf[4];
    { const bf16_t* qp = MQ + (tokb + qpos) * 256 + h * 64 + hi * 8;
#pragma unroll
      for (int s = 0; s < 4; ++s) qf[s] = *(const bf16x8*)(qp + 16 * s); }
    unsigned selmask = 0u;
    {
        float g[8];
#pragma unroll
        for (int j = 0; j < 8; ++j) {
            g[j] = -INFINITY;
            if (j < qb) {
                const float* km = kmean + (size_t)(b * 8 + j) * 256 + h * 64 + hi * 8; float a = 0.f;
#pragma unroll
                for (int s = 0; s < 4; ++s) { const f32x4 k0 = *(const f32x4*)(km + 16 * s), k1 = *(const f32x4*)(km + 16 * s + 4);
#pragma unroll
                    for (int e = 0; e < 4; ++e) { a += bf2f((bf16_t)qf[s][e]) * k0[e]; a += bf2f((bf16_t)qf[s][4 + e]) * k1[e]; } }
                g[j] = a + __shfl_xor(a, 32);
            }
        }
#pragma unroll
        for (int j = 0; j < 8; ++j) {
            int rank = 0;
#pragma unroll
            for (int i = 0; i < 8; ++i) if (i != j) rank += (g[i] > g[j] || (g[i] == g[j] && i < j)) ? 1 : 0;
            if (j < qb && rank < 3) selmask |= 1u << j;
        }
    }
    const int NT = 4 * (qb + 1);
    const bf16_t* kg0 = MKp + (tokb + (tid >> 3)) * 256 + h * 64 + (tid & 7) * 8;
    const bf16_t* vg0 = Vt + (size_t)(512 + h * 64 + (tid >> 3)) * MTOK + tokb + (tid & 7) * 8;
    u32x4 ka0, va0, kb0, vb0;
#define M_LOAD(S, t) do { k##S##0 = *(const u32x4*)(kg0 + (size_t)(t) * 64 * 256); v##S##0 = *(const u32x4*)(vg0 + (t) * 64); } while (0)
#define M_STORE(S, buf) do { *(LAS u32x4*)(lds + M_LK + (buf) * MK_BUF + (tid >> 3) * 144 + (tid & 7) * 16) = k##S##0; vt_store(lds + M_LV + (buf) * MK_BUF, tid >> 3, tid & 7, v##S##0); } while (0)
#define M_COMPUTE(t, cur) do { const int j_ = (t) >> 2; const bool own_ = (j_ == qb); const bool allowed_ = own_ ? true : (((selmask >> j_) & 1u) != 0u); \
        const bool active_ = own_ ? (64 * (t) <= q0 + 31) : (__any(allowed_ ? 1 : 0) != 0); \
        if (active_) { \
            f32x16 p0, p1; \
            qk_tile<144>(p0, p1, lds + M_LK + (cur) * MK_BUF, qf, q, hi); \
            if (own_) { if (64 * (t) + 63 > q0) { \
                _Pragma("unroll") for (int r = 0; r < 16; ++r) { const int kk = 64 * (t) + crow(r, hi); if (kk > qpos) p0[r] = -INFINITY; if (kk + 32 > qpos) p1[r] = -INFINITY; } } } \
            else if (!allowed_) { _Pragma("unroll") for (int r = 0; r < 16; ++r) { p0[r] = -INFINITY; p1[r] = -INFINITY; } } \
            softmax_step<2>(p0, p1, m_run, l_run, o); \
            bf16x8 pk[4]; pack_p(pk, p0, p1); \
            pv_tile<2>(o, lds + M_LV + (cur) * MK_BUF, pk, q, hi); } } while (0)
    float m_run = -1e30f, l_run = 0.f;
    f32x16 o[2];
#pragma unroll
    for (int i = 0; i < 2; ++i)
#pragma unroll
        for (int r = 0; r < 16; ++r) o[i][r] = 0.f;
    M_LOAD(a, 0); M_STORE(a, 0); M_LOAD(b, 1); ATT_BAR();
    for (int t = 0; t < NT; t += 2) {
        { const int tl = (t + 2 < NT) ? t + 2 : NT - 1; M_LOAD(a, tl); }
        M_COMPUTE(t, 0);
        M_STORE(b, 1);
        ATT_BAR();
        { const int tl = (t + 3 < NT) ? t + 3 : NT - 1; M_LOAD(b, tl); }
        M_COMPUTE(t + 1, 1);
        if (t + 2 < NT) M_STORE(a, 0);
        ATT_BAR();
    }
#undef M_LOAD
#undef M_STORE
#undef M_COMPUTE
    const float l_tot = l_run + __shfl_xor(l_run, 32), inv = 1.0f / l_tot;
    LAS unsigned char* stg = lds + M_STG + wid * 4608;
#pragma unroll
    for (int i = 0; i < 2; ++i)
#pragma unroll
        for (int r4 = 0; r4 < 4; ++r4) {
            const int dv = 32 * i + 8 * r4 + 4 * hi;
            u32x2 w; w.x = cvt_pk_bf16(o[i][4 * r4 + 0] * inv, o[i][4 * r4 + 1] * inv); w.y = cvt_pk_bf16(o[i][4 * r4 + 2] * inv, o[i][4 * r4 + 3] * inv);
            *(LAS u32x2*)(stg + q * 144 + dv * 2) = w;
        }
    LDS_WAIT(); asm volatile("" ::: "memory");
    bf16_t* yo = Y + (tokb + q0) * DM + 768 + h * 64;
#pragma unroll
    for (int i = 0; i < 4; ++i) { const int id = i * 64 + lane, rw = id >> 3, c = id & 7;
        const u32x4 v = *(const LAS u32x4*)(stg + rw * 144 + c * 16); *(u32x4*)(yo + (size_t)rw * DM + c * 8) = v; }
    __syncthreads();
}

constexpr int PL_US = 0, PL_P16 = 40448, PL_WT = 74240, PL_PSTR = 528, PL_WSTR = 144;
__device__ __forceinline__ void pool_stage_w(const float* pw, LAS unsigned char* lds) {
    int tid_ = threadIdx.x; asm volatile("" : "+v"(tid_)); const int lane = tid_ & 63; const int wid = __builtin_amdgcn_readfirstlane(tid_ >> 6);
    const int g = wid >> 1, th = wid & 1;
    const float* wp = pw + (size_t)(g * 64 + th * 32) * 64 + lane;
    float v[32];
#pragma unroll
    for (int i = 0; i < 32; ++i) v[i] = wp[i * 64];
    LAS unsigned char* wt = lds + PL_WT + (g * 64 + lane) * PL_WSTR + th * 64;
#pragma unroll
    for (int i = 0; i < 16; ++i) *(LAS unsigned*)(wt + 4 * i) = cvt_pk_bf16(v[2 * i], v[2 * i + 1]);
}
__device__ __forceinline__ void pool_unit(int item, const bf16_t* U, const float* psc, bf16_t* Y, LAS unsigned char* lds) {
    int tid_ = threadIdx.x; asm volatile("" : "+v"(tid_)); const int tid = tid_; const int tok0 = item * 64, t0 = tok0 & (SEQ - 1);
    LAS bf16_t* Us = (LAS bf16_t*)(lds + PL_US);
    {
        u32x4 uv[5];
#pragma unroll
        for (int k = 0; k < 5; ++k) { const int id = tid + 512 * k, r = id >> 5, c = id & 31, trel = r - 15;
            uv[k] = (u32x4){0u, 0u, 0u, 0u};
            if (id < 79 * 32 && t0 + trel >= 0) uv[k] = *(const u32x4*)(U + (ptrdiff_t)(tok0 + trel) * 256 + c * 8); }
#pragma unroll
        for (int k = 0; k < 5; ++k) { const int id = tid + 512 * k; if (id < 79 * 32) *(LAS u32x4*)(Us + (id >> 5) * 256 + (id & 31) * 8) = uv[k]; }
    }
    __syncthreads();
    {
        const int c = tid & 255, hf = tid >> 8, g = c >> 6, w = 2 << g;
        const LAS bf16_t* up = Us + (15 + hf * 32) * 256 + c;
        LAS unsigned char* pp = lds + PL_P16 + (hf * 32) * PL_PSTR + c * 2;
        float s = 0.f;
        for (int k = 1; k < w; ++k) s += bf2f(up[-k * 256]);
#pragma unroll 8
        for (int i = 0; i < 32; ++i) {
            const int t = t0 + hf * 32 + i; const float ut = bf2f(up[i * 256]);
            s += ut;
            const int cnt = (t + 1 < w) ? (t + 1) : w;
            const float val = s * __builtin_amdgcn_rcpf((float)cnt) - ut;
            *(LAS bf16_t*)(pp + i * PL_PSTR) = (bf16_t)(cvt_pk_bf16(val, 0.f) & 0xffffu);
            s -= bf2f(up[(i - w + 1) * 256]);
        }
    }
    __syncthreads();
    {
        const int lane = tid & 63, q = lane & 31, hi = lane >> 5; const int wid = __builtin_amdgcn_readfirstlane(tid >> 6);
        const int g = wid >> 1, th = wid & 1;
        const LAS unsigned char* pa = lds + PL_P16 + (th * 32 + q) * PL_PSTR + (g * 64 + 8 * hi) * 2;
        const LAS unsigned char* wb = lds + PL_WT + (g * 64 + q) * PL_WSTR + 8 * hi * 2;
        const f32x16 z = {0.f, 0.f, 0.f, 0.f, 0.f, 0.f, 0.f, 0.f, 0.f, 0.f, 0.f, 0.f, 0.f, 0.f, 0.f, 0.f};
        f32x16 acc0 = z, acc1 = z;
#pragma unroll
        for (int s4 = 0; s4 < 4; ++s4) {
            const bf16x8 a = *(const LAS bf16x8*)(pa + s4 * 32);
            const bf16x8 b0 = *(const LAS bf16x8*)(wb + s4 * 32), b1 = *(const LAS bf16x8*)(wb + 32 * PL_WSTR + s4 * 32);
            acc0 = __builtin_amdgcn_mfma_f32_32x32x16_bf16(a, b0, acc0, 0, 0, 0);
            acc1 = __builtin_amdgcn_mfma_f32_32x32x16_bf16(a, b1, acc1, 0, 0, 0);
        }
        const float sc0 = psc[g * 64 + q], sc1 = psc[g * 64 + 32 + q];
        bf16_t* yo = Y + (size_t)(tok0 + th * 32) * DM + g * 64 + q;
#pragma unroll
        for (int r = 0; r < 16; ++r) { const int tk = crow(r, hi);
            yo[(size_t)tk * DM] = (bf16_t)(cvt_pk_bf16(acc0[r] * sc0, 0.f) & 0xffffu);
            yo[(size_t)tk * DM + 32] = (bf16_t)(cvt_pk_bf16(acc1[r] * sc1, 0.f) & 0xffffu); }
    }
    __syncthreads();
}

#include <hip/hip_bf16.h>
#include <cmath>
namespace moba_body {
using bf16=__hip_bfloat16;
using bf16x8=__attribute__((ext_vector_type(8)))short;
using s16x4=__attribute__((ext_vector_type(4)))short;
using f32x16=__attribute__((ext_vector_type(16)))float;
using u32x4=__attribute__((ext_vector_type(4)))unsigned;
using f32x4_t=__attribute__((ext_vector_type(4)))float;
constexpr int BATCH=16,NHEAD=4,SEQ=2048,D=64,DM=NHEAD*D,OP=1024,OCOL=768;
constexpr int NW=8,QBLK=32,QB=QBLK*NW,KVBLK=64,NQB=SEQ/QB;
constexpr int ATTN_PITCH=DM, ATTN_UNIT_ROWS=QB;
__device__ __forceinline__ int crow(int r,int hi){return (r&3)+8*(r>>2)+4*hi;}
#define SBAR() __builtin_amdgcn_sched_barrier(0)
__device__ __forceinline__ void cmask(f32x16&p0,f32x16&p1,int jb,int qrel,int hi){
  const float NEG=-INFINITY; int kb=64*jb+4*hi;
  #pragma unroll
  for(int r=0;r<16;++r){int kv=kb+(r&3)+8*(r>>2); if(kv>qrel)p0[r]=NEG; if(kv+32>qrel)p1[r]=NEG;}
}

constexpr int NSLOT=3, SLOTB=8192;
constexpr int LDS_K=0, LDS_V=NSLOT*SLOTB, LDS_WS=2*NSLOT*SLOTB, LDS_OST=LDS_WS+NW*64*4, LDS_BYTES=LDS_OST+NW*4096;
constexpr float C2=0.125f*1.4426950408889634f;
__device__ __forceinline__ void glds16(const void*gsrc,unsigned lds_dst){unsigned keep;
  asm volatile("s_mov_b32 %0, m0\n\ts_mov_b32 m0, %2\n\ts_nop 0\n\tglobal_load_lds_dwordx4 %1, off\n\ts_mov_b32 m0, %0":"=&s"(keep):"v"(gsrc),"s"(lds_dst):"memory");}
__device__ __forceinline__ float max3f(float a,float b,float c){float r;asm("v_max3_f32 %0, %1, %2, %3":"=v"(r):"v"(a),"v"(b),"v"(c));return r;}
__device__ __forceinline__ float max2f(float a,float b){float r;asm("v_max_f32_e32 %0, %1, %2":"=v"(r):"v"(a),"v"(b));return r;}
__device__ __forceinline__ float fadd_s(float a,float b){float r;asm("v_add_f32_e32 %0, %1, %2":"=v"(r):"v"(a),"v"(b));return r;}
__device__ __forceinline__ float fsub_s(float a,float b){float r;asm("v_sub_f32_e32 %0, %1, %2":"=v"(r):"v"(a),"v"(b));return r;}
typedef float f32x2_t __attribute__((ext_vector_type(2))); typedef __bf16 bf16x2_t __attribute__((ext_vector_type(2)));
__device__ __forceinline__ unsigned cvtpk_s(float lo,float hi){f32x2_t v={lo,hi};bf16x2_t b=__builtin_convertvector(v,bf16x2_t);return __builtin_bit_cast(unsigned,b);}
#define WAIT_BAR(N) asm volatile("s_waitcnt vmcnt(" #N ") lgkmcnt(0)\n\ts_barrier":::"memory")

__device__ __forceinline__ void qkt(f32x16&p0,f32x16&p1,const char*Kslot,const bf16x8*qr,int r32,int hi){ const f32x16 zf={0.f,0.f,0.f,0.f,0.f,0.f,0.f,0.f,0.f,0.f,0.f,0.f,0.f,0.f,0.f,0.f};
  const char*kb=Kslot+hi*1024+r32*16;
  #pragma unroll
  for(int d0=0;d0<4;++d0){
    const bf16x8 b0=*reinterpret_cast<const bf16x8*>(kb+d0*2048);
    const bf16x8 b1=*reinterpret_cast<const bf16x8*>(kb+d0*2048+512);
    if(d0==0){p0=__builtin_amdgcn_mfma_f32_32x32x16_bf16(b0,qr[0],zf,0,0,0);p1=__builtin_amdgcn_mfma_f32_32x32x16_bf16(b1,qr[0],zf,0,0,0);}
    else{p0=__builtin_amdgcn_mfma_f32_32x32x16_bf16(b0,qr[d0],p0,0,0,0);p1=__builtin_amdgcn_mfma_f32_32x32x16_bf16(b1,qr[d0],p1,0,0,0);}}
}
typedef __attribute__((address_space(3))) const char* lds_cptr;
typedef short v4i16_t __attribute__((ext_vector_type(4)));
__device__ __forceinline__ void kload8(bf16x8*kf,lds_cptr kp){
  kf[0]=*(const __attribute__((address_space(3))) bf16x8*)(kp);      kf[1]=*(const __attribute__((address_space(3))) bf16x8*)(kp+512);
  kf[2]=*(const __attribute__((address_space(3))) bf16x8*)(kp+2048); kf[3]=*(const __attribute__((address_space(3))) bf16x8*)(kp+2560);
  kf[4]=*(const __attribute__((address_space(3))) bf16x8*)(kp+4096); kf[5]=*(const __attribute__((address_space(3))) bf16x8*)(kp+4608);
  kf[6]=*(const __attribute__((address_space(3))) bf16x8*)(kp+6144); kf[7]=*(const __attribute__((address_space(3))) bf16x8*)(kp+6656);
}
__device__ __forceinline__ void kload2(bf16x8*kf,lds_cptr kp,int j){ kf[2*j]=*(const __attribute__((address_space(3))) bf16x8*)(kp+j*2048); kf[2*j+1]=*(const __attribute__((address_space(3))) bf16x8*)(kp+j*2048+512); }
__device__ __forceinline__ s16x4 vtr(lds_cptr p){ return __builtin_bit_cast(s16x4,__builtin_amdgcn_ds_read_tr16_b64_v4i16((__attribute__((address_space(3))) v4i16_t*)p)); }
__device__ __forceinline__ float rowmax(const f32x16&p0,const f32x16&p1){
  float a=max3f(p0[0],p0[1],p1[0]),b=max3f(p0[2],p0[3],p1[1]);a=max3f(a,p1[2],p1[3]);
  #pragma unroll
  for(int r=4;r<16;r+=4){a=max3f(a,p0[r],p0[r+1]);b=max3f(b,p0[r+2],p0[r+3]);a=max3f(a,p1[r],p1[r+1]);b=max3f(b,p1[r+2],p1[r+3]);}
  const float m=max2f(a,b);
  auto rr=__builtin_amdgcn_permlane32_swap(__float_as_uint(m),__float_as_uint(m),false,false);
  return max2f(__uint_as_float(rr[0]),__uint_as_float(rr[1]));
}
__device__ __forceinline__ void pv(f32x16*o,int vb,bf16x8 pa0,bf16x8 pa1,bf16x8 pa2,bf16x8 pa3){
  #pragma unroll
  for(int d0=0;d0<2;++d0){s16x4 lo[4],hi[4];
    #pragma unroll
    for(int ks=0;ks<4;++ks){
      asm volatile("ds_read_b64_tr_b16 %0,%1 offset:%c2":"=&v"(lo[ks]):"v"(vb),"i"(d0*4096+ks*1024):"memory");
      asm volatile("ds_read_b64_tr_b16 %0,%1 offset:%c2":"=&v"(hi[ks]):"v"(vb),"i"(d0*4096+ks*1024+512):"memory");}
    asm volatile("s_waitcnt lgkmcnt(0)":::"memory");SBAR();
    #define PK(k) (bf16x8){lo[k][0],lo[k][1],lo[k][2],lo[k][3],hi[k][0],hi[k][1],hi[k][2],hi[k][3]}
    o[d0]=__builtin_amdgcn_mfma_f32_32x32x16_bf16(pa0,PK(0),o[d0],0,0,0);
    o[d0]=__builtin_amdgcn_mfma_f32_32x32x16_bf16(pa1,PK(1),o[d0],0,0,0);
    o[d0]=__builtin_amdgcn_mfma_f32_32x32x16_bf16(pa2,PK(2),o[d0],0,0,0);
    o[d0]=__builtin_amdgcn_mfma_f32_32x32x16_bf16(pa3,PK(3),o[d0],0,0,0);
    #undef PK
  }
}

#ifndef ATTN_STORE16
#define ATTN_STORE16(p,v) (*(u32x4*)(p)=(v))
#endif
template<int THRL> __device__ __forceinline__ void attn_unit(int b,int h,int qb,const bf16*Q,const bf16*__restrict__ K,const bf16*__restrict__ V,bf16*O,char*shm,const float*__restrict__ kmean){
  int tid_=threadIdx.x; asm volatile("":"+v"(tid_)); const int tid=tid_,lane=tid&63,r32=lane&31,hi=lane>>5; const int wid=__builtin_amdgcn_readfirstlane(tid>>6);
  const long rowbase=(long)b*SEQ; const int q0=qb*QB;
  const bf16*Qw=Q+(rowbase+q0+wid*QBLK)*DM+h*D;
  const bf16*Kh=K+rowbase*DM+h*D,*Vh=V+rowbase*DM+h*D;
  const unsigned lds0=(unsigned)(uintptr_t)shm;
  float*wsf=(float*)(shm+LDS_WS)+wid*64;
  const bf16*ksrc=Kh+(long)lane*DM+wid*8;
  const bf16*vsrc=Vh+(long)(16*(wid&3)+(lane>>2))*DM+(wid>>2)*32+(lane&3)*8;
  const unsigned kdst=lds0+LDS_K+wid*1024, vdst=lds0+LDS_V+wid*1024;
  #define DMA_K(t,slot) glds16(ksrc+(long)(t)*KVBLK*DM,(unsigned)__builtin_amdgcn_readfirstlane(kdst+(slot)))
  #define DMA_V(t,slot) glds16(vsrc+(long)(t)*KVBLK*DM,(unsigned)__builtin_amdgcn_readfirstlane(vdst+(slot)))
  const int vb0=(int)(lds0+LDS_V)+((lane>>4)&1)*32+(lane&3)*8+(4*hi+((lane&15)>>2))*64;
  const char*Kbase=shm+LDS_K; bf16x8 kf[8];
  const lds_cptr shm3=(lds_cptr)shm; const lds_cptr kp0=shm3+LDS_K+hi*1024+r32*16; const lds_cptr vp0=shm3+LDS_V+((lane>>4)&1)*32+(lane&3)*8+(4*hi+((lane&15)>>2))*64;
  const int NT=(q0+QB)/KVBLK;
  DMA_K(0,0);DMA_V(0,0);DMA_K(1,SLOTB);
  bf16x8 qr[4];
  #pragma unroll
  for(int d0=0;d0<4;++d0)qr[d0]=*reinterpret_cast<const bf16x8*>(&Qw[(long)r32*DM+d0*16+hi*8]);
  unsigned selmask=0u; const bool gate_any=(qb>3);
  if(gate_any){ float g_[8];
    #pragma unroll
    for(int j=0;j<8;++j){ g_[j]=-INFINITY;
      if(j<qb){ const float*km=kmean+(size_t)(b*8+j)*256+h*64+hi*8; float a_=0.f;
        #pragma unroll
        for(int s_=0;s_<4;++s_){ const f32x4_t k0=*(const f32x4_t*)(km+16*s_),k1=*(const f32x4_t*)(km+16*s_+4);
          #pragma unroll
          for(int e=0;e<4;++e){ a_+=__uint_as_float((unsigned)(unsigned short)qr[s_][e]<<16)*k0[e]; a_+=__uint_as_float((unsigned)(unsigned short)qr[s_][4+e]<<16)*k1[e]; } }
        g_[j]=a_+__shfl_xor(a_,32); } }
    #pragma unroll
    for(int j=0;j<8;++j){ int rank=0;
      #pragma unroll
      for(int i=0;i<8;++i) if(i!=j) rank+=(g_[i]>g_[j]||(g_[i]==g_[j]&&i<j))?1:0;
      if(j<qb&&rank<3) selmask|=1u<<j; } }
  else selmask=0xffu;
  #define GATE(P0,P1,t) do{ if(gate_any){ const bool al_=((selmask>>((t)>>2))&1u)!=0u; if(!al_){ _Pragma("unroll") for(int r=0;r<16;++r){P0[r]=-INFINITY;P1[r]=-INFINITY;} } } }while(0)
  float mhat=0.f,l_reg=0.f;f32x16 o[2];o[0]=f32x16{};o[1]=f32x16{};const f32x16 zf={0.f,0.f,0.f,0.f,0.f,0.f,0.f,0.f,0.f,0.f,0.f,0.f,0.f,0.f,0.f,0.f};
  const int qrel=wid*QBLK+r32;
  #define CMASK(P0,P1,t) do{int jb_=(t)-(NT-4); if(jb_>=0)cmask(P0,P1,jb_,qrel,hi); else GATE(P0,P1,t);}while(0)
  bool resc=false;
  #define START(P0,P1) do{ const float rm=rowmax(P0,P1); resc=false; \
    { const float dl=(rm>-1e30f)?rm:0.f; mhat=fadd_s(mhat,dl); \
      _Pragma("unroll") for(int r=0;r<16;++r){P0[r]=fsub_s(P0[r],dl);P1[r]=fsub_s(P1[r],dl);} \
      } \
    _Pragma("unroll") for(int r=0;r<16;++r)P0[r]=__builtin_amdgcn_exp2f(P0[r]); }while(0)
  #define RESC() do{ if(resc){ asm volatile("s_waitcnt lgkmcnt(0)":::"memory"); \
      _Pragma("unroll") for(int d_=0;d_<2;++d_) _Pragma("unroll") for(int r=0;r<16;++r)o[d_][r]*=wsf[crow(r,hi)]; } }while(0)
  f32x16 pA0,pA1,pB0,pB1;
  int sl_prev=0,sl_cur=0,sl_next=SLOTB;
  #define ROT() do{sl_prev=sl_cur;sl_cur=sl_next;sl_next=(sl_next==(NSLOT-1)*SLOTB)?0:sl_next+SLOTB;}while(0)
  DMA_K(2,2*SLOTB);
  WAIT_BAR(3);
  qkt(pA0,pA1,Kbase,qr,r32,hi);asm volatile("s_nop 15\n\ts_nop 7":"+v"(pA0),"+v"(pA1));CMASK(pA0,pA1,0);
  START(pA0,pA1);
  _Pragma("unroll") for(int r=0;r<16;++r)pA1[r]=__builtin_amdgcn_exp2f(pA1[r]);
  WAIT_BAR(0);
  DMA_K(3,0);DMA_V(1,SLOTB);
  ROT();
  kload8(kf,kp0+sl_cur);
  WAIT_BAR(2);
  s16x4 vlo[8],vhi[8]; u32x4 pw0,pw1,pw2,pw3;
  #define PKW(P,B) cvtpk_s(P[B],P[B+1])
  #define PAF(k) __builtin_bit_cast(bf16x8,pw##k)
  #define VFR(i) (bf16x8){vlo[i][0],vlo[i][1],vlo[i][2],vlo[i][3],vhi[i][0],vhi[i][1],vhi[i][2],vhi[i][3]}
  #define PIN(x) asm volatile("":"+v"(x))
  #define MX3(a,b,c) __builtin_fmaxf(__builtin_fmaxf((a),(b)),(c))
  #define GAPA(MF,A0,A1,A2,A3,W0,W1,PW) do{ MF; sacc+=A0; sacc+=A1; sacc+=A2; sacc+=A3; PIN(sacc); W0; W1; PIN(PW); SBAR(); }while(0)
  #define EX(v) __builtin_amdgcn_exp2f(v)
  #define GAPB(MF,X,B) do{ MF; X[B]=EX(X[B]-mhat); X[B+1]=EX(X[B+1]-mhat); X[B+2]=EX(X[B+2]-mhat); X[B+3]=EX(X[B+3]-mhat); PIN(X); SBAR(); }while(0)
  #define VRD(i) do{ vlo[i]=vtr(vp_+(((i)>>2)*4096+((i)&3)*1024)); vhi[i]=vtr(vp_+(((i)>>2)*4096+((i)&3)*1024+512)); }while(0)
  #define KRD(G,j) do{ if(G){ kload2(kf,kp0+sl_next,j); SBAR(); } }while(0)
  #define STEP(C0,C1,P0,P1,t,GK,GV,GL) do{ SBAR(); \
    const lds_cptr vp_=vp0+sl_prev; \
    VRD(0); SBAR(); float sacc=(P0[0]+P0[1]); \
    GAPA(C0=__builtin_amdgcn_mfma_f32_32x32x16_bf16(kf[0],qr[0],zf,0,0,0), P0[2],P0[3],P0[4],P0[5],     pw0[0]=PKW(P0,0), pw0[1]=PKW(P0,2), pw0); \
    VRD(4); SBAR(); GAPA(C1=__builtin_amdgcn_mfma_f32_32x32x16_bf16(kf[1],qr[0],zf,0,0,0), P0[6],P0[7],P0[8],P0[9],     pw0[2]=PKW(P0,4), pw0[3]=PKW(P0,6), pw0); \
    VRD(1); SBAR(); GAPA(C0=__builtin_amdgcn_mfma_f32_32x32x16_bf16(kf[2],qr[1],C0,0,0,0),   P0[10],P0[11],P0[12],P0[13], pw1[0]=PKW(P0,8), pw1[1]=PKW(P0,10), pw1); \
    VRD(5); SBAR(); GAPA(C1=__builtin_amdgcn_mfma_f32_32x32x16_bf16(kf[3],qr[1],C1,0,0,0),   P0[14],P0[15],P1[0],P1[1],   pw1[2]=PKW(P0,12),pw1[3]=PKW(P0,14), pw1); \
    VRD(2); SBAR(); GAPA(C0=__builtin_amdgcn_mfma_f32_32x32x16_bf16(kf[4],qr[2],C0,0,0,0),   P1[2],P1[3],P1[4],P1[5],     pw2[0]=PKW(P1,0), pw2[1]=PKW(P1,2), pw2); \
    VRD(6); SBAR(); GAPA(C1=__builtin_amdgcn_mfma_f32_32x32x16_bf16(kf[5],qr[2],C1,0,0,0),   P1[6],P1[7],P1[8],P1[9],     pw2[2]=PKW(P1,4), pw2[3]=PKW(P1,6), pw2); \
    VRD(3); SBAR(); GAPA(C0=__builtin_amdgcn_mfma_f32_32x32x16_bf16(kf[6],qr[3],C0,0,0,0),   P1[10],P1[11],P1[12],P1[13], pw3[0]=PKW(P1,8), pw3[1]=PKW(P1,10), pw3); \
    VRD(7); SBAR(); GAPA(C1=__builtin_amdgcn_mfma_f32_32x32x16_bf16(kf[7],qr[3],C1,0,0,0),   P1[14],P1[15],0.f,0.f,       pw3[2]=PKW(P1,12),pw3[3]=PKW(P1,14), pw3); \
    l_reg+=sacc; \
    if(GK){DMA_K((t)+3,sl_cur);} if(GV){DMA_V((t)+1,sl_next);} \
    CMASK(C0,C1,t); \
    { float a=MX3(C0[0],C0[1],C1[0]),b=MX3(C0[2],C0[3],C1[1]); a=MX3(a,C1[2],C1[3]); \
      _Pragma("unroll") for(int r=4;r<16;r+=4){a=MX3(a,C0[r],C0[r+1]);b=MX3(b,C0[r+2],C0[r+3]);a=MX3(a,C1[r],C1[r+1]);b=MX3(b,C1[r+2],C1[r+3]);} \
      float rm=__builtin_fmaxf(a,b); { auto rr=__builtin_amdgcn_permlane32_swap(__float_as_uint(rm),__float_as_uint(rm),false,false); rm=__builtin_fmaxf(__uint_as_float(rr[0]),__uint_as_float(rr[1])); } \
      rm-=mhat; resc=false; \
      if(__builtin_expect(__any(rm>(float)THRL),0)){ const float dl=__builtin_fmaxf(rm,0.f); mhat+=dl; \
        const float f=__builtin_amdgcn_exp2f(-dl); l_reg*=f; if(hi==0)wsf[r32]=f; resc=true; } } \
    SBAR(); \
    GAPB(o[0]=__builtin_amdgcn_mfma_f32_32x32x16_bf16(PAF(0),VFR(0),o[0],0,0,0), C0,0); \
    GAPB(o[1]=__builtin_amdgcn_mfma_f32_32x32x16_bf16(PAF(0),VFR(4),o[1],0,0,0), C0,4); \
    KRD(GL,0); GAPB(o[0]=__builtin_amdgcn_mfma_f32_32x32x16_bf16(PAF(1),VFR(1),o[0],0,0,0), C0,8); \
    KRD(GL,1); GAPB(o[1]=__builtin_amdgcn_mfma_f32_32x32x16_bf16(PAF(1),VFR(5),o[1],0,0,0), C0,12); \
    KRD(GL,2); GAPB(o[0]=__builtin_amdgcn_mfma_f32_32x32x16_bf16(PAF(2),VFR(2),o[0],0,0,0), C1,0); \
    KRD(GL,3); GAPB(o[1]=__builtin_amdgcn_mfma_f32_32x32x16_bf16(PAF(2),VFR(6),o[1],0,0,0), C1,4); \
    GAPB(o[0]=__builtin_amdgcn_mfma_f32_32x32x16_bf16(PAF(3),VFR(3),o[0],0,0,0), C1,8); \
    GAPB(o[1]=__builtin_amdgcn_mfma_f32_32x32x16_bf16(PAF(3),VFR(7),o[1],0,0,0), C1,12); \
    }while(0)
  int t=1;
  #undef CMASK
  #define CMASK(P0,P1,t) GATE(P0,P1,t)
  for(;t+5<NT;t+=2){
    STEP(pB0,pB1,pA0,pA1,t,true,true,true);     WAIT_BAR(2); RESC(); ROT();
    STEP(pA0,pA1,pB0,pB1,t+1,true,true,true);   WAIT_BAR(2); RESC(); ROT();
  }
  #undef CMASK
  #define CMASK(P0,P1,t) do{int jb_=(t)-(NT-4); if(jb_>=0)cmask(P0,P1,jb_,qrel,hi); else GATE(P0,P1,t);}while(0)
  #define ENDW(tt) do{ if((tt)+3<NT){WAIT_BAR(2);} else if((tt)+2<NT){WAIT_BAR(1);} else {WAIT_BAR(0);} }while(0)
  for(;t+1<NT;t+=2){
    STEP(pB0,pB1,pA0,pA1,t,(t+3<NT),(t+1<NT),(t+1<NT));       ENDW(t);   RESC(); ROT();
    STEP(pA0,pA1,pB0,pB1,t+1,(t+4<NT),(t+2<NT),(t+2<NT));     ENDW(t+1); RESC(); ROT();
  }
  STEP(pB0,pB1,pA0,pA1,NT-1,false,false,false); RESC();
  { float sacc=pB0[0]+pB0[1]; _Pragma("unroll") for(int r=2;r<16;++r)sacc+=pB0[r]; _Pragma("unroll") for(int r=0;r<16;++r)sacc+=pB1[r]; l_reg+=sacc;
    pw0=(u32x4){PKW(pB0,0),PKW(pB0,2),PKW(pB0,4),PKW(pB0,6)};pw1=(u32x4){PKW(pB0,8),PKW(pB0,10),PKW(pB0,12),PKW(pB0,14)};pw2=(u32x4){PKW(pB1,0),PKW(pB1,2),PKW(pB1,4),PKW(pB1,6)};pw3=(u32x4){PKW(pB1,8),PKW(pB1,10),PKW(pB1,12),PKW(pB1,14)};
    SBAR(); pv(o,vb0+sl_cur,PAF(0),PAF(1),PAF(2),PAF(3)); }
  #undef PKW
  #undef PAF
  #undef VFR
  #undef PIN
  #undef MX3
  #undef GAPA
  #undef GAPB
  #undef EX
  #undef VRD
  #undef KRD
  #undef STEP
  #undef ENDW
  {auto rr=__builtin_amdgcn_permlane32_swap(__float_as_uint(l_reg),__float_as_uint(l_reg),false,false);l_reg=__uint_as_float(rr[0])+__uint_as_float(rr[1]);}
  if(hi==0)wsf[32+r32]=l_reg;asm volatile("s_waitcnt lgkmcnt(0)":::"memory");
  float rli[16];
  #pragma unroll
  for(int r=0;r<16;++r)rli[r]=__builtin_amdgcn_rcpf(wsf[32+crow(r,hi)]);
  bf16*Ow=O+(rowbase+q0+wid*QBLK)*OP+OCOL+h*D;
  { bf16*stg=(bf16*)(shm+LDS_OST)+wid*2048;
    #pragma unroll
    for(int r=0;r<16;++r){const int orow=crow(r,hi);
      #pragma unroll
      for(int d0=0;d0<2;++d0)stg[orow*64+d0*32+r32]=__float2bfloat16(o[d0][r]*rli[r]);}
    asm volatile("s_waitcnt lgkmcnt(0)":::"memory");
    #pragma unroll
    for(int i=0;i<4;++i){const int row=i*8+(lane>>3),ch=lane&7; const u32x4 v=*(const u32x4*)(stg+row*64+ch*8); ATTN_STORE16(Ow+(long)row*OP+ch*8,v);} }
  asm volatile("s_waitcnt lgkmcnt(0)\n\ts_barrier":::"memory");
  #undef DMA_K
  #undef DMA_V
  #undef GATE
  #undef CMASK
  #undef START
  #undef RESC
  #undef ROT
}
constexpr int ATTN_LDS_BYTES=LDS_BYTES;
#undef SBAR
#undef WAIT_BAR
}

#define XB_TMO      128
#define XB_XCNT(j)  (256  + 64 * (j))
#define XB_XSUB(j)  (1280 + 64 * (j))
#define XB_XGEN(j)  (2304 + 64 * (j))
#define XB_TOP      3328
#define XB_TOPGEN   3392
#define XCD_BAR_WORDS 3456
#define XB_SPIN_CAP (1u << 18)

__device__ __forceinline__ unsigned xb_ld(unsigned* p)              { return __hip_atomic_load(p, __ATOMIC_RELAXED, __HIP_MEMORY_SCOPE_AGENT); }
__device__ __forceinline__ unsigned xb_add(unsigned* p, unsigned v) { return __hip_atomic_fetch_add(p, v, __ATOMIC_RELAXED, __HIP_MEMORY_SCOPE_AGENT); }
__device__ __forceinline__ unsigned xb_xcc_id() { return (unsigned)__builtin_amdgcn_s_getreg((3 << 11) | 20) & 0xFu; }
#define XB_SPIN(cond, bar) do { unsigned _sp = 0; while (cond) { __builtin_amdgcn_s_sleep(1); \
    if ((++_sp & 255u) == 0u) { if (xb_ld(&(bar)[XB_TMO])) break; if (_sp > XB_SPIN_CAP) { atomicAdd(&(bar)[XB_TMO], 1u); break; } } } } while (0)

struct XcdBarrier {
    unsigned* bar; unsigned x;
    volatile LAS unsigned* st;
};

__device__ __forceinline__ XcdBarrier xcd_barrier_post(unsigned* bar, volatile LAS unsigned* st) {
    XcdBarrier b; b.bar = bar; b.x = xb_xcc_id(); b.st = st;
    if (threadIdx.x == 0) (void)xb_add(&bar[XB_XCNT(b.x)], 1u);
    return b;
}
__device__ __forceinline__ void xcd_barrier_complete(unsigned* bar, unsigned x, unsigned& nloc, unsigned& nx) {
    const unsigned G = gridDim.x * gridDim.y * gridDim.z;
    unsigned sum, cnt, mine, sp = 0u;
    for (;;) {
        sum = 0u; cnt = 0u; mine = 0u;
#pragma unroll
        for (unsigned j = 0; j < 16; ++j) { const unsigned c = xb_ld(&bar[XB_XCNT(j)]); sum += c; cnt += (c > 0u) ? 1u : 0u; mine = (j == x) ? c : mine; }
        if (sum == G) break;
        __builtin_amdgcn_s_sleep(1);
        if ((++sp & 255u) == 0u) { if (xb_ld(&bar[XB_TMO])) break; if (sp > XB_SPIN_CAP) { atomicAdd(&bar[XB_TMO], 1u); break; } }
    }
    nloc = mine > 0u ? mine : 1u; nx = cnt > 0u ? cnt : 1u;
}

__device__ __forceinline__ void xcd_barrier(const XcdBarrier& b) {
    asm volatile("s_waitcnt vmcnt(0)" ::: "memory");
    __syncthreads();
    if (threadIdx.x == 0) {
        unsigned* bar = b.bar;
        __builtin_amdgcn_s_waitcnt(0);
        unsigned nloc = b.st[0], nx = b.st[1];
        if (nloc == 0u) { xcd_barrier_complete(bar, b.x, nloc, nx); b.st[0] = nloc; b.st[1] = nx; }
        const unsigned old = xb_add(&bar[XB_XSUB(b.x)], 1u);
        const unsigned gen = old / nloc;
        if (old + 1u == (gen + 1u) * nloc) {
            __builtin_amdgcn_fence(__ATOMIC_RELEASE, "agent");
            asm volatile("s_waitcnt vmcnt(0)" ::: "memory");
            const unsigned og = xb_add(&bar[XB_TOP], 1u);
            const unsigned tg = og / nx;
            if (og + 1u == (tg + 1u) * nx) xb_add(&bar[XB_TOPGEN], 1u);
            else XB_SPIN(xb_ld(&bar[XB_TOPGEN]) == tg, bar);
            __builtin_amdgcn_fence(__ATOMIC_ACQUIRE, "agent");
            xb_add(&bar[XB_XGEN(b.x)], 1u);
            asm volatile("s_waitcnt vmcnt(0)" ::: "memory");
        } else {
            XB_SPIN(xb_ld(&bar[XB_XGEN(b.x)]) == gen, bar);
            __builtin_amdgcn_fence(__ATOMIC_ACQUIRE, "agent");
            asm volatile("s_waitcnt vmcnt(0)" ::: "memory");
        }
    }
    __syncthreads();
}

struct Params { const float* in[15]; float* out; unsigned char* ws; float inv_freq[32]; float lam_init[2]; int pad[2]; };
enum { I_X = 0, I_F1N, I_F1WI, I_F1WO, I_MN, I_MWI, I_MWO, I_PW, I_PS, I_DL, I_DS, I_F2N, I_F2WI, I_F2WO, I_FN };

__global__ void __launch_bounds__(512, 2) fwd_megakernel(Params p) {
    extern __shared__ __attribute__((aligned(16))) unsigned char lds_raw[];
    LAS unsigned char* lds = (LAS unsigned char*)lds_raw;
    cg::grid_group grid = cg::this_grid();
    if (threadIdx.x < 2) ((volatile LAS unsigned*)(lds + LDS_BYTES - 64))[threadIdx.x] = 0u;
    __syncthreads();
    if (p.ws == nullptr) grid.sync();
    XcdBarrier xbar = xcd_barrier_post((unsigned*)(p.ws + WS_SSQ) + 7 * MTOK, (volatile LAS unsigned*)(lds + LDS_BYTES - 64));
#define GRID_BAR() xcd_barrier(xbar)
    const int tid = threadIdx.x, lane = tid & 63; const int wave = __builtin_amdgcn_readfirstlane(tid >> 6);
    const int G = gridDim.x, bx = blockIdx.x, vcu = (G % 8 == 0) ? (bx % 8) * (G / 8) + bx / 8 : bx;
    const int gw = vcu * 8 + wave, NGW = G * 8;
    unsigned char* ws = p.ws;
    float* zreg = (float*)(ws + WS_SSQ); float* ssq = (float*)(ws + WS_SSQ16); float* kmean = (float*)(ws + WS_KMEAN);
    float* cosT = (float*)(ws + WS_COS); float* sinT = (float*)(ws + WS_SIN);
    bf16_t* XB = (bf16_t*)(ws + WS_XB); bf16_t* H = (bf16_t*)(ws + WS_H);
    bf16_t* U = (bf16_t*)(ws + WS_U); bf16_t* DQ = (bf16_t*)(ws + WS_DQ); bf16_t* DKb = (bf16_t*)(ws + WS_DK); bf16_t* MQ = (bf16_t*)(ws + WS_MQ); bf16_t* MKb = (bf16_t*)(ws + WS_MK);
    bf16_t* VT = (bf16_t*)(ws + WS_VT); bf16_t* MV = (bf16_t*)(ws + WS_MV); bf16_t* Y = (bf16_t*)(ws + WS_Y);
    float* out = p.out;

#ifdef PROBE_PRO2
    for (int rep_ = 0; rep_ < 2; ++rep_)
#endif
    {
        LAS float* scr = (LAS float*)(lds + wave * 16640);
        constexpr int I_W1 = (DM / 64) * (2 * DFF / 64), I_W2 = (DFF / 64) * (DM / 64), I_MI = (DM / 64) * (2560 / 64), I_MO = (DM / 64) * (DM / 64);
        constexpr int PER_LAYER = 2 * I_W1 + 2 * I_W2 + I_MI + I_MO;
        for (int it = gw; it < DEPTH * PER_LAYER; it += NGW) {
            const int l = it / PER_LAYER; int r = it % PER_LAYER;
            unsigned char* wl = ws + WS_W + (size_t)l * W_LAYER;
            if (r < I_W1) { transpose_item(p.in[I_F1WI] + (size_t)l * DM * 2 * DFF, DM, 2 * DFF, p.in[I_F1N] + l * DM, 1, (bf16_t*)(wl + WO_W1A), nullptr, scr, r, lane); continue; } r -= I_W1;
            if (r < I_W1) { transpose_item(p.in[I_F2WI] + (size_t)l * DM * 2 * DFF, DM, 2 * DFF, p.in[I_F2N] + l * DM, 1, (bf16_t*)(wl + WO_W1B), nullptr, scr, r, lane); continue; } r -= I_W1;
            if (r < I_W2) { transpose_item(p.in[I_F1WO] + (size_t)l * DFF * DM, DFF, DM, nullptr, 0, (bf16_t*)(wl + WO_W2A), nullptr, scr, r, lane); continue; } r -= I_W2;
            if (r < I_W2) { transpose_item(p.in[I_F2WO] + (size_t)l * DFF * DM, DFF, DM, nullptr, 0, (bf16_t*)(wl + WO_W2B), nullptr, scr, r, lane); continue; } r -= I_W2;
            if (r < I_MI) { transpose_item(p.in[I_MWI] + (size_t)l * DM * 2560, DM, 2560, p.in[I_MN] + l * DM, 2, (bf16_t*)(wl + WO_WQK), (bf16_t*)(wl + WO_WV), scr, r, lane); continue; } r -= I_MI;
            transpose_item(p.in[I_MWO] + (size_t)l * DM * DM, DM, DM, nullptr, 0, (bf16_t*)(wl + WO_WO), nullptr, scr, r, lane);
        }
        const float* x = p.in[I_X];
        for (int m = gw; m < MTOK; m += 2 * NGW) {
            const int m1 = m + NGW; const bool has1 = m1 < MTOK;
            const f32x4* xr0 = (const f32x4*)(x + (size_t)m * DM) + lane; const f32x4* xr1 = (const f32x4*)(x + (size_t)(has1 ? m1 : m) * DM) + lane;
            f32x4 v0[4], v1[4]; float s0 = 0.f, s1 = 0.f;
#pragma unroll
            for (int j = 0; j < 4; ++j) { v0[j] = xr0[64 * j]; v1[j] = xr1[64 * j]; }
#pragma unroll
            for (int j = 0; j < 4; ++j) { s0 += (v0[j][0] * v0[j][0] + v0[j][1] * v0[j][1]) + (v0[j][2] * v0[j][2] + v0[j][3] * v0[j][3]); s1 += (v1[j][0] * v1[j][0] + v1[j][1] * v1[j][1]) + (v1[j][2] * v1[j][2] + v1[j][3] * v1[j][3]); }
            s0 = wave_sum(s0); s1 = wave_sum(s1);
            u32x2* o0 = (u32x2*)(XB + (size_t)m * DM) + lane; u32x2* o1 = (u32x2*)(XB + (size_t)m1 * DM) + lane;
#pragma unroll
            for (int j = 0; j < 4; ++j) { u32x2 w; w.x = cvt_pk_bf16(v0[j][0], v0[j][1]); w.y = cvt_pk_bf16(v0[j][2], v0[j][3]); o0[64 * j] = w; }
            if (has1) {
#pragma unroll
                for (int j = 0; j < 4; ++j) { u32x2 w; w.x = cvt_pk_bf16(v1[j][0], v1[j][1]); w.y = cvt_pk_bf16(v1[j][2], v1[j][3]); o1[64 * j] = w; }
            }
            if (lane < 16) { ssq[(size_t)m * 16 + lane] = lane == 0 ? s0 : 0.f; if (has1) ssq[(size_t)m1 * 16 + lane] = lane == 0 ? s1 : 0.f; }
        }
        for (int idx = gw * 64 + lane; idx < SEQ * 32; idx += NGW * 64) {
            const int pos = idx >> 5, i = idx & 31; const float ang = (float)pos * p.inv_freq[i];
            double rev = (double)ang * 0.15915494309189535; rev -= floor(rev); const float fr = (float)rev;
            cosT[idx] = __builtin_amdgcn_cosf(fr); sinT[idx] = __builtin_amdgcn_sinf(fr);
        }
        for (int idx = gw * 64 + lane; idx < 2 * 128 * 256; idx += NGW * 64) kmean[idx] = 0.f;
    }
    GRID_BAR();

#ifdef PROBE_SYNC16
    for (int rep_ = 0; rep_ < 16; ++rep_) GRID_BAR();
#endif
#pragma unroll 1
    for (int l = 0; l < DEPTH; ++l) {
        unsigned char* wl = ws + WS_W + (size_t)l * W_LAYER;
        float* kml = kmean + (size_t)l * 128 * 256;
        { pg8::Gemm g{XB, (const bf16_t*)(wl + WO_W1A), MTOK, 2 * DFF, DM}; asm volatile("" : "+s"(g.A), "+s"(g.Bt)); pg8::StaticOrder S; S.init(MTOK, 2 * DFF, G, bx);
          LAS float* tab = (LAS float*)(lds + RSTD_TAB_OFF); build_rstd_tab<false>(tab, ssq + (size_t)(3 * l) * MTOK * 16, S); __syncthreads();
          EpiSwiglu E{H, tab};
#ifdef PROBE_FFNIN2
          for (int rep_ = 0; rep_ < 2; ++rep_)
#endif
#ifndef NO_EPISWIGLU
          pg8::gemm_phase<EpiSwiglu, pg8::StaticOrder, PG8_ALIGN, PG8_SP2>(lds, g, S, E);
#endif
        }
        GRID_BAR();
        { pg8::Gemm g{H, (const bf16_t*)(wl + WO_W2A), MTOK, DM, DFF}; asm volatile("" : "+s"(g.A), "+s"(g.Bt)); pg8::StaticOrder S; S.init(MTOK, DM, G, bx);
          EpiResid E{XB, ssq + (size_t)(3 * l + 1) * MTOK * 16, 0.5f};
#ifndef NO_EPIRESID
          pg8::gemm_phase<EpiResid, pg8::StaticOrder, PG8_ALIGN, PG8_SP2>(lds, g, S, E);
#endif
        }
        GRID_BAR();
        { pg8::Gemm g{XB, (const bf16_t*)(wl + WO_WQK), MTOK, NQK, DM}; asm volatile("" : "+s"(g.A), "+s"(g.Bt)); pg8::StaticOrder S; S.init(MTOK, NQK, G, bx);
          LAS float* tab = (LAS float*)(lds + RSTD_TAB_OFF); build_rstd_tab<false>(tab, ssq + (size_t)(3 * l + 1) * MTOK * 16, S);
          { pg8::StaticOrder S2; S2.init(NVC, MTOK, G, (bx + G / 2) % G); build_rstd_tab<true>(tab + 8 * 256, ssq + (size_t)(3 * l + 1) * MTOK * 16, S2); }
          __syncthreads();
          EpiQK E{U, DQ, DKb, MQ, MKb, MV, tab, cosT, sinT, kml};
#ifndef NO_EPIQK
          pg8::gemm_phase<EpiQK, pg8::StaticOrder, PG8_ALIGN, PG8_SP2>(lds, g, S, E);
#endif
        }
        { pg8::Gemm g{(const bf16_t*)(wl + WO_WV), XB, NVC, MTOK, DM}; asm volatile("" : "+s"(g.A), "+s"(g.Bt)); pg8::StaticOrder S; S.init(NVC, MTOK, G, (bx + G / 2) % G);
          EpiVt E{VT, (const LAS float*)(lds + RSTD_TAB_OFF) + 8 * 256};
#ifndef NO_EPIVT
          pg8::gemm_phase<EpiVt, pg8::StaticOrder, PG8_ALIGN, PG8_SP2>(lds, g, S, E);
#endif
        }
        GRID_BAR();
        {
#ifdef PROBE_ATTN2
            for (int rep_ = 0; rep_ < 2; ++rep_) {
#else
            {
#endif
            const float* lamw = p.in[I_DL] + l * 256; const float* subg = p.in[I_DS] + l * 128; const float lam_init = p.lam_init[l];
            { int ts_ = threadIdx.x; asm volatile("" : "+v"(ts_)); if (ts_ < 128) ((LAS float*)(lds + RSTD_TAB_OFF))[ts_] = subg[ts_]; }
            float la_ = 0.f, lc_ = 0.f;
            for (int i = 0; i < 64; ++i) { la_ += lamw[i] * lamw[64 + i]; lc_ += lamw[128 + i] * lamw[192 + i]; }
            const float lam = __builtin_amdgcn_exp2f(la_ * 1.4426950408889634f) - __builtin_amdgcn_exp2f(lc_ * 1.4426950408889634f) + lam_init;
#ifdef PROBE_DIFF2
            for (int rep2_ = 0; rep2_ < 2; ++rep2_)
#endif
            for (int it = vcu; it < 512; it += G) {
                const int bh = it >> 3, s = it & 7;
#ifndef NO_DIFF
                diff_unit(bh >> 2, bh & 3, 15 - s, DQ, DKb, VT, Y, lam, subg, lam_init, lds);
                diff_unit(bh >> 2, bh & 3, s, DQ, DKb, VT, Y, lam, subg, lam_init, lds);
#endif
            }
#ifdef PROBE_MOBA2
            for (int rep2_ = 0; rep2_ < 2; ++rep2_)
#endif
            for (int it = vcu; it < 256; it += G) {
                const int bh = it >> 2, s = it & 3;
#ifndef NO_MOBA
                moba_body::attn_unit<8>(bh >> 2, bh & 3, 7 - s, (const moba_body::bf16*)MQ, (const moba_body::bf16*)MKb, (const moba_body::bf16*)MV, (moba_body::bf16*)Y, (char*)lds_raw, kml);
                moba_body::attn_unit<8>(bh >> 2, bh & 3, s, (const moba_body::bf16*)MQ, (const moba_body::bf16*)MKb, (const moba_body::bf16*)MV, (moba_body::bf16*)Y, (char*)lds_raw, kml);
#endif
            }
#ifndef NO_POOL
            pool_stage_w(p.in[I_PW] + l * 4 * 64 * 64, lds);
            for (int it = vcu; it < MTOK / 64; it += G) pool_unit(it, U, p.in[I_PS] + l * 256, Y, lds);
#endif
            }
        }
        GRID_BAR();
        { pg8::Gemm g{Y, (const bf16_t*)(wl + WO_WO), MTOK, DM, DM}; asm volatile("" : "+s"(g.A), "+s"(g.Bt)); pg8::StaticOrder S; S.init(MTOK, DM, G, bx);
          EpiResid E{XB, ssq + (size_t)(3 * l + 2) * MTOK * 16, 1.0f};
#ifndef NO_EPIRESID
          pg8::gemm_phase<EpiResid, pg8::StaticOrder, PG8_ALIGN, PG8_SP2>(lds, g, S, E);
#endif
        }
        GRID_BAR();
        { pg8::Gemm g{XB, (const bf16_t*)(wl + WO_W1B), MTOK, 2 * DFF, DM}; asm volatile("" : "+s"(g.A), "+s"(g.Bt)); pg8::StaticOrder S; S.init(MTOK, 2 * DFF, G, bx);
          LAS float* tab = (LAS float*)(lds + RSTD_TAB_OFF); build_rstd_tab<false>(tab, ssq + (size_t)(3 * l + 2) * MTOK * 16, S); __syncthreads();
          EpiSwiglu E{H, tab};
#ifndef NO_EPISWIGLU
          pg8::gemm_phase<EpiSwiglu, pg8::StaticOrder, PG8_ALIGN, PG8_SP2>(lds, g, S, E);
#endif
        }
        GRID_BAR();
        { pg8::Gemm g{H, (const bf16_t*)(wl + WO_W2B), MTOK, DM, DFF}; asm volatile("" : "+s"(g.A), "+s"(g.Bt)); pg8::StaticOrder S; S.init(MTOK, DM, G, bx);
          EpiResid E{XB, ssq + (size_t)(3 * l + 3) * MTOK * 16, 0.5f};
#ifndef NO_EPIRESID
          pg8::gemm_phase<EpiResid, pg8::StaticOrder, PG8_ALIGN, PG8_SP2>(lds, g, S, E);
#endif
        }
        GRID_BAR();
    }
    {
        const float* fg = p.in[I_FN]; const float* sq = ssq + (size_t)(3 * DEPTH) * MTOK * 16;
        int tl_ = threadIdx.x; asm volatile("" : "+v"(tl_)); const int lane = tl_ & 63;
        for (int m0 = gw; m0 < MTOK; m0 += 4 * NGW) {
            u32x2 w[4][4]; float rs[4];
#pragma unroll
            for (int k = 0; k < 4; ++k) { const int m = m0 + k * NGW; const u32x2* xr = (const u32x2*)(XB + (size_t)m * DM) + lane;
#pragma unroll
                for (int j = 0; j < 4; ++j) w[k][j] = xr[64 * j];
                rs[k] = row_rstd(sq, m); }
#pragma unroll
            for (int k = 0; k < 4; ++k) { const int m = m0 + k * NGW; f32x4* orow = (f32x4*)(out + (size_t)m * DM) + lane; const f32x4* gr = (const f32x4*)fg + lane;
#pragma unroll
                for (int j = 0; j < 4; ++j) { const f32x4 g4 = gr[64 * j]; f32x4 v;
                    v[0] = __uint_as_float(w[k][j].x << 16); v[1] = __uint_as_float(w[k][j].x & 0xffff0000u); v[2] = __uint_as_float(w[k][j].y << 16); v[3] = __uint_as_float(w[k][j].y & 0xffff0000u);
                    orow[64 * j] = v * rs[k] * g4; } }
        }
    }
}

extern "C" void kernel_launch(void* const* d_in, const int* in_sizes, int n_in, void* d_out, int out_size, void* d_ws, size_t ws_size, hipStream_t stream) {
    static int grid = 0;
    if (grid == 0) {
        if (n_in != 15 || in_sizes[0] != MTOK * DM || out_size != MTOK * DM || ws_size < WS_TOTAL) { fprintf(stderr, "kernel_launch: unexpected shapes / workspace (n_in %d, ws %zu)\n", n_in, ws_size); grid = -1; return; }
        int dev = 0, cus = 0, per_cu = 0;
        hipGetDevice(&dev); hipDeviceGetAttribute(&cus, hipDeviceAttributeMultiprocessorCount, dev);
        if (hipFuncSetAttribute((const void*)fwd_megakernel, hipFuncAttributeMaxDynamicSharedMemorySize, LDS_BYTES) != hipSuccess) { fprintf(stderr, "kernel_launch: hipFuncSetAttribute failed\n"); grid = -1; return; }
        if (hipOccupancyMaxActiveBlocksPerMultiprocessor(&per_cu, (const void*)fwd_megakernel, 512, LDS_BYTES) != hipSuccess || per_cu < 1) per_cu = 1;
        (void)hipGetLastError();
        grid = cus * per_cu;
        if (grid != 256) { fprintf(stderr, "kernel_launch: built for a 256-workgroup cooperative grid (got %d)\n", grid); grid = -1; return; }
    }
    if (grid < 0) return;
    Params p{};
    for (int i = 0; i < 15; ++i) p.in[i] = (const float*)d_in[i];
    p.out = (float*)d_out; p.ws = (unsigned char*)d_ws;
    for (int i = 0; i < 32; ++i) p.inv_freq[i] = powf(10000.0f, -(float)(2 * i) / 64.0f);
    for (int l = 0; l < 2; ++l) p.lam_init[l] = (float)(0.8 - 0.6 * exp(-0.3 * (double)l));
    if (hipMemsetAsync((char*)d_ws + WS_SSQ + (size_t)7 * MTOK * 4, 0, XCD_BAR_WORDS * 4, stream) != hipSuccess) { fprintf(stderr, "kernel_launch: memset of the barrier words failed\n"); return; }
    void* args[] = {&p};
    hipError_t e = hipLaunchCooperativeKernel((const void*)fwd_megakernel, dim3(grid), dim3(512), args, LDS_BYTES, stream);
    if (e != hipSuccess) fprintf(stderr, "cooperative launch failed: %s (grid %d)\n", hipGetErrorString(e), grid);
}
```

```cpp
#include <hip/hip_runtime.h>
#include <hip/hip_cooperative_groups.h>
#include <cstdio>
#include <cstdint>
#include <cmath>
namespace cg = cooperative_groups;
namespace pg8 {
#define PG8_LAS __attribute__((address_space(3)))
typedef unsigned short bf16_t;
typedef short bf16x8 __attribute__((ext_vector_type(8)));
typedef float f32x4 __attribute__((ext_vector_type(4)));
typedef unsigned u32x4 __attribute__((ext_vector_type(4)));
constexpr int BM = 256, BK = 64, HALF = 128, HTB = HALF * BK * 2  , STAGE_BYTES = 8 * HTB, NXCD = 8, WGM = 8;

__host__ __device__ __forceinline__ int lds_byte(int r, int c) { const int st = (r >> 4) * 2 + (c >> 5), rr = r & 15, cc = c & 31, ob = rr * 64 + cc * 2; return st * 1024 + (ob ^ (((ob >> 9) & 1) << 5)); }
__host__ __device__ __forceinline__ void stage_rc(int b, int& R, int& C) { const int st = b / 1024, sb = b % 1024, swz = sb ^ (((sb >> 9) & 1) << 5); R = (st >> 1) * 16 + swz / 64; C = (st & 1) * 32 + (swz % 64) / 2; }
__host__ __device__ __forceinline__ int perm32(int rho) { const int n = rho >> 4, i = rho & 15; return 8 * (i >> 2) + 4 * n + (i & 3); }

struct Unit { int pm, pn, idx; };
struct Gemm { const bf16_t* A; const bf16_t* Bt; int M, N, K; };

struct StaticOrder {
    int nM, nN, nwg, G, c;
    __host__ __device__ void init(int M, int N, int G_, int c_) { nM = M / BM; nN = N / BM; nwg = nM * nN; G = G_; c = c_; }
    __host__ __device__ bool next(int i, Unit& u) const {
        const long L = (long)i * G + c; if (L >= nwg) return false;
        int wgid = (int)L; { const int q = nwg / NXCD, r = nwg % NXCD, xcd = wgid % NXCD, off = wgid / NXCD; wgid = (xcd < r ? xcd * (q + 1) : r * (q + 1) + (xcd - r) * q) + off; }
        const int nig = WGM * nN, gid = wgid / nig, fm = gid * WGM, gsz = (nM - fm) < WGM ? (nM - fm) : WGM;
        u.pm = fm + ((wgid % nig) % gsz); u.pn = (wgid % nig) / gsz; u.idx = i; return true;
    }
    __device__ __forceinline__ void a_ready(const Unit&) const {}
    __device__ __forceinline__ void done(const Unit&) const {}
};

__device__ __forceinline__ unsigned cvt_pk_bf16(float lo, float hi) { unsigned r; asm volatile("v_cvt_pk_bf16_f32 %0, %1, %2" : "=v"(r) : "v"(lo), "v"(hi)); return r; }
typedef float f32x2 __attribute__((ext_vector_type(2)));
template <class Epi, class Sched, bool ALIGN_EPI = false, bool SP2 = false>
__device__ __forceinline__ void gemm_phase(PG8_LAS unsigned char* lds, const Gemm g, const Sched& S, const Epi& E) {
    int tid_ = threadIdx.x; asm volatile("" : "+v"(tid_));
    const int tid = tid_, wid = __builtin_amdgcn_readfirstlane(tid >> 6), lane = tid & 63, wr = wid >> 2, wc = wid & 3, fr = lane & 15, fq = lane >> 4;
    const int K = g.K, nt = K / BK;
    unsigned voffA[2], voffB[2];
#pragma unroll
    for (int i = 0; i < 2; ++i) { int R, C; stage_rc(tid * 16 + i * 8192, R, C); const int Rb = Epi::PERM ? ((R & ~31) + perm32(R & 31)) : R;
        voffA[i] = (unsigned)(R * K + C) * 2u; voffB[i] = (unsigned)(Rb * K + C) * 2u; }
    const size_t kstep = (size_t)(BK * 2);
    const size_t hstep = (size_t)HALF * K * 2;
    const size_t tstep = 2 * hstep;
    const unsigned ldsw = (unsigned)wid * 1024u;
    const int aoff = lds_byte(wr * 64 + fr, fq * 8), boff = lds_byte(wc * 32 + fr, fq * 8);
#define PG8_SA(b, h) (((b) * 2 + (h)) * HTB)
#define PG8_SB(b, h) ((4 + (b) * 2 + (h)) * HTB)
#define PG8_STAGE(bufoff, gbase, voff) do { _Pragma("unroll") for (int _i = 0; _i < 2; ++_i) \
        __builtin_amdgcn_global_load_lds((const unsigned*)((const char*)(gbase) + (voff)[_i]), (PG8_LAS unsigned*)(lds + (bufoff) + ldsw + _i * 8192), 16, 0, 0); } while (0)
#define PG8_LDA(dst, b, h) do { _Pragma("unroll") for (int m = 0; m < 4; ++m) _Pragma("unroll") for (int k = 0; k < 2; ++k) dst[m][k] = *(const PG8_LAS bf16x8*)(lds + PG8_SA(b, h) + aoff + m * 2048 + k * 1024); } while (0)
#define PG8_LDB(dst, b, h) do { _Pragma("unroll") for (int n = 0; n < 2; ++n) _Pragma("unroll") for (int k = 0; k < 2; ++k) dst[n][k] = *(const PG8_LAS bf16x8*)(lds + PG8_SB(b, h) + boff + n * 2048 + k * 1024); } while (0)
#define PG8_MMA(ai, bj, At, Bt) do { __builtin_amdgcn_s_setprio(1); _Pragma("unroll") for (int m = 0; m < 4; ++m) _Pragma("unroll") for (int n = 0; n < 2; ++n) _Pragma("unroll") for (int k = 0; k < 2; ++k) \
        acc[ai][bj][m][n] = __builtin_amdgcn_mfma_f32_16x16x32_bf16(Bt[n][k], At[m][k], acc[ai][bj][m][n], 0, 0, 0); __builtin_amdgcn_s_setprio(0); } while (0)
#define PG8_WAIT_V(n) asm volatile("s_waitcnt vmcnt(" #n ")" ::: "memory")
#define PG8_WAIT_L(n) asm volatile("s_waitcnt lgkmcnt(" #n ")" ::: "memory")
#define PG8_BAR __builtin_amdgcn_s_barrier()
#define PG8_SCHED __builtin_amdgcn_sched_barrier(0)
    Unit cur, nxt; int ui = 0;
    if (!S.next(0, cur)) return;
    f32x4 acc[2][2][4][2];
#pragma unroll
    for (int a = 0; a < 2; ++a)
#pragma unroll
        for (int b = 0; b < 2; ++b)
#pragma unroll
            for (int m = 0; m < 4; ++m)
#pragma unroll
                for (int n = 0; n < 2; ++n) acc[a][b][m][n] = (f32x4){0.f, 0.f, 0.f, 0.f};
    bf16x8 At[4][2], B0[2][2], B1[2][2];
    const char* cA = (const char*)g.A + (size_t)cur.pm * tstep; const char* cB = (const char*)g.Bt + (size_t)cur.pn * tstep;
    S.a_ready(cur);
    if constexpr (SP2) {
        PG8_STAGE(PG8_SB(0, 0), cB, voffB); PG8_STAGE(PG8_SB(0, 1), cB + hstep, voffB); PG8_STAGE(PG8_SA(0, 0), cA, voffA); PG8_STAGE(PG8_SA(0, 1), cA + hstep, voffA);
        if (wr == 1) PG8_BAR;
        PG8_WAIT_V(2); PG8_BAR;
        PG8_STAGE(PG8_SB(1, 0), cB + kstep, voffB); PG8_STAGE(PG8_SA(1, 0), cA + kstep, voffA); PG8_STAGE(PG8_SB(1, 1), cB + hstep + kstep, voffB);
        PG8_WAIT_V(6); PG8_BAR;
    } else {
        PG8_STAGE(PG8_SB(0, 0), cB, voffB); PG8_STAGE(PG8_SA(0, 0), cA, voffA); PG8_STAGE(PG8_SB(0, 1), cB + hstep, voffB); PG8_STAGE(PG8_SA(0, 1), cA + hstep, voffA);
        if (wr == 1) PG8_BAR;
        PG8_WAIT_V(4); PG8_BAR;
        PG8_STAGE(PG8_SB(1, 0), cB + kstep, voffB); PG8_STAGE(PG8_SA(1, 0), cA + kstep, voffA); PG8_STAGE(PG8_SB(1, 1), cB + hstep + kstep, voffB);
        PG8_WAIT_V(6); PG8_BAR;
    }
    for (;;) {
        const bool has_next = S.next(ui + 1, nxt);
        const char* nA = has_next ? (const char*)g.A + (size_t)nxt.pm * tstep : cA; const char* nB = has_next ? (const char*)g.Bt + (size_t)nxt.pn * tstep : cB;
        for (int t = 0; t < nt; t += 2) {
            const bool last = (t == nt - 2);
            const char* a1 = cA + (size_t)(t + 1) * kstep;
            const char* a2 = last ? nA : cA + (size_t)(t + 2) * kstep; const char* b2 = last ? nB : cB + (size_t)(t + 2) * kstep;
            const char* a3 = a2 + kstep; const char* b3 = b2 + kstep;
            if (last && has_next) S.a_ready(nxt);
            if constexpr (SP2) {
            PG8_LDB(B0, 0, 0); PG8_LDB(B1, 0, 1); PG8_SCHED; PG8_LDA(At, 0, 0); PG8_STAGE(PG8_SA(1, 1), a1 + hstep, voffA);
            PG8_WAIT_V(8); PG8_WAIT_L(0); PG8_BAR; PG8_MMA(0, 0, At, B0); PG8_MMA(0, 1, At, B1); PG8_BAR; PG8_SCHED;
            PG8_LDA(At, 0, 1); PG8_STAGE(PG8_SB(0, 0), b2, voffB); PG8_STAGE(PG8_SB(0, 1), b2 + hstep, voffB); PG8_STAGE(PG8_SA(0, 0), a2, voffA);
            PG8_WAIT_V(8); PG8_WAIT_L(0); PG8_BAR; PG8_MMA(1, 0, At, B0); PG8_MMA(1, 1, At, B1); PG8_BAR; PG8_SCHED;
            PG8_LDB(B0, 1, 0); PG8_LDB(B1, 1, 1); PG8_SCHED; PG8_LDA(At, 1, 0); PG8_STAGE(PG8_SA(0, 1), a2 + hstep, voffA);
            PG8_WAIT_V(8); PG8_WAIT_L(0); PG8_BAR; PG8_MMA(0, 0, At, B0); PG8_MMA(0, 1, At, B1); PG8_BAR; PG8_SCHED;
            PG8_LDA(At, 1, 1); PG8_STAGE(PG8_SB(1, 0), b3, voffB); PG8_STAGE(PG8_SB(1, 1), b3 + hstep, voffB); PG8_STAGE(PG8_SA(1, 0), a3, voffA);
            PG8_WAIT_V(8); PG8_WAIT_L(0); PG8_BAR; PG8_MMA(1, 0, At, B0); PG8_MMA(1, 1, At, B1); PG8_BAR; PG8_SCHED;
            } else {
            PG8_LDB(B0, 0, 0); PG8_SCHED; PG8_LDA(At, 0, 0); PG8_STAGE(PG8_SA(1, 1), a1 + hstep, voffA);
            PG8_WAIT_L(8); PG8_BAR; PG8_WAIT_L(0); PG8_MMA(0, 0, At, B0); PG8_BAR; PG8_SCHED;
            PG8_LDB(B1, 0, 1); PG8_STAGE(PG8_SB(0, 0), b2, voffB);
            PG8_BAR; PG8_WAIT_L(0); PG8_MMA(0, 1, At, B1); PG8_BAR;
            PG8_LDA(At, 0, 1); PG8_STAGE(PG8_SA(0, 0), a2, voffA);
            PG8_BAR; PG8_WAIT_L(0); PG8_MMA(1, 0, At, B0); PG8_BAR; PG8_SCHED;
            PG8_STAGE(PG8_SB(0, 1), b2 + hstep, voffB);
            PG8_WAIT_V(6); PG8_BAR; PG8_MMA(1, 1, At, B1); PG8_BAR;
            PG8_LDB(B0, 1, 0); PG8_SCHED; PG8_LDA(At, 1, 0); PG8_STAGE(PG8_SA(0, 1), a2 + hstep, voffA);
            PG8_WAIT_L(8); PG8_BAR; PG8_WAIT_L(0); PG8_MMA(0, 0, At, B0); PG8_BAR; PG8_SCHED;
            PG8_LDB(B1, 1, 1); PG8_STAGE(PG8_SB(1, 0), b3, voffB);
            PG8_BAR; PG8_WAIT_L(0); PG8_MMA(0, 1, At, B1); PG8_BAR;
            PG8_LDA(At, 1, 1); PG8_STAGE(PG8_SA(1, 0), a3, voffA);
            PG8_BAR; PG8_WAIT_L(0); PG8_MMA(1, 0, At, B0); PG8_BAR; PG8_SCHED;
            PG8_STAGE(PG8_SB(1, 1), b3 + hstep, voffB);
            PG8_WAIT_V(6); PG8_BAR; PG8_MMA(1, 1, At, B1); PG8_BAR;
            }
        }
        if constexpr (ALIGN_EPI) { if (wr == 0) PG8_BAR; }
        if constexpr (!Epi::AFTER_DRAIN) { E(acc, cur, wr, wc, fr, fq); S.done(cur); }
        if (!has_next) break;
#pragma unroll
        for (int a = 0; a < 2; ++a)
#pragma unroll
            for (int b = 0; b < 2; ++b)
#pragma unroll
                for (int m = 0; m < 4; ++m)
#pragma unroll
                    for (int n = 0; n < 2; ++n) acc[a][b][m][n] = (f32x4){0.f, 0.f, 0.f, 0.f};
        cur = nxt; cA = nA; cB = nB; ++ui;
        if constexpr (ALIGN_EPI) { if (wr == 1) PG8_BAR; }
    }
    PG8_WAIT_V(0);
    if constexpr (!ALIGN_EPI) { if (wr == 0) PG8_BAR; }
    PG8_BAR;
    if constexpr (Epi::AFTER_DRAIN) { E.fused(acc, cur, wr, wc, fr, fq, lds, wid, lane); S.done(cur); }
#undef PG8_SA
#undef PG8_SB
#undef PG8_STAGE
#undef PG8_LDA
#undef PG8_LDB
#undef PG8_MMA
#undef PG8_WAIT_V
#undef PG8_WAIT_L
#undef PG8_BAR
#undef PG8_SCHED
}
}

#ifndef PG8_SP2
#define PG8_SP2 true
#endif
#ifndef PG8_ALIGN
#define PG8_ALIGN true
#endif
#define LAS __attribute__((address_space(3)))
typedef unsigned short bf16_t;
typedef short bf16x8 __attribute__((ext_vector_type(8)));
typedef float f32x4 __attribute__((ext_vector_type(4)));
typedef float f32x16 __attribute__((ext_vector_type(16)));
typedef unsigned u32x4 __attribute__((ext_vector_type(4)));
typedef unsigned u32x2 __attribute__((ext_vector_type(2)));
constexpr int BATCH = 16, SEQ = 2048, DM = 1024, DEPTH = 2, MTOK = BATCH * SEQ, DFF = 2816, NQK = 2048, NVC = 512;
constexpr float NORM_EPS = 1e-6f;
constexpr float QSCALE = 0.125f * 1.4426950408889634f;
constexpr size_t MiB = 1u << 20;
constexpr size_t WS_SSQ16 = 372 * MiB, WS_TOTAL = 388 * MiB;
constexpr size_t WS_SSQ = 0, WS_KMEAN = 1 * MiB, ZERO_FLOATS = (1 * MiB + 2 * 128 * 256 * 4) / 4;
constexpr size_t WS_COS = 2 * MiB, WS_SIN = 2 * MiB + 256 * 1024;
constexpr size_t WS_W = 4 * MiB, W_LAYER = 40 * MiB;
constexpr size_t WO_W1A = 0, WO_W2A = 11 * MiB, WO_WQK = 16 * MiB + 512 * 1024, WO_WV = 20 * MiB + 512 * 1024, WO_WO = 21 * MiB + 512 * 1024, WO_W1B = 23 * MiB + 512 * 1024, WO_W2B = 34 * MiB + 512 * 1024;
constexpr size_t WS_XB = 84 * MiB, WS_H = 148 * MiB;
constexpr size_t WS_U = 148 * MiB, WS_DQ = 164 * MiB, WS_DK = 196 * MiB, WS_MQ = 228 * MiB, WS_MK = 244 * MiB, WS_VT = 260 * MiB, WS_MV = 292 * MiB, WS_Y = 308 * MiB, WS_END = 372 * MiB;
constexpr int LDS_BYTES = 147456;

using pg8::cvt_pk_bf16;
__device__ __forceinline__ float bf2f(bf16_t v) { return __uint_as_float((unsigned)v << 16); }
__device__ __forceinline__ float wave_sum(float v) {
#pragma unroll
    for (int o = 1; o < 64; o <<= 1) v += __shfl_xor(v, o);
    return v;
}
#define LDS_WAIT() asm volatile("s_waitcnt lgkmcnt(0)" ::: "memory")

__device__ __forceinline__ float row_ssq(const float* part, int row) {
    const f32x4* p = (const f32x4*)(part + (size_t)row * 16); const f32x4 a = p[0], b = p[1], c = p[2], d = p[3];
    return (((a[0] + a[1]) + (a[2] + a[3])) + ((b[0] + b[1]) + (b[2] + b[3]))) + (((c[0] + c[1]) + (c[2] + c[3])) + ((d[0] + d[1]) + (d[2] + d[3])));
}
__device__ __forceinline__ float row_rstd(const float* part, int row) { return __builtin_amdgcn_rsqf(row_ssq(part, row) * (1.0f / DM) + NORM_EPS); }
constexpr int RSTD_TAB_OFF = 131072, RSTD_TAB_UNITS = 14;
template <bool BYPN> __device__ __forceinline__ void build_rstd_tab(LAS float* tab, const float* part, const pg8::StaticOrder& S) {
    int tid_ = threadIdx.x; asm volatile("" : "+v"(tid_)); const int row = tid_ >> 1, hf = tid_ & 1;
    pg8::Unit u; int prev_base = -1;
    for (int i = 0; i < RSTD_TAB_UNITS && S.next(i, u); ++i) {
        const int base = (BYPN ? u.pn : u.pm) * 256;
        if (base == prev_base) {
            if (hf == 0) tab[i * 256 + row] = tab[(i - 1) * 256 + row];
            continue;
        }
        prev_base = base;
        const f32x4* p = (const f32x4*)(part + (size_t)(base + row) * 16 + hf * 8); const f32x4 a = p[0], b = p[1];
        const float s = ((a[0] + a[1]) + (a[2] + a[3])) + ((b[0] + b[1]) + (b[2] + b[3])); const float o = __shfl_xor(s, 1);
        const float tot = hf ? (o + s) : (s + o);
        if (hf == 0) tab[i * 256 + row] = __builtin_amdgcn_rsqf(tot * (1.0f / DM) + NORM_EPS);
    }
}
struct EpiSwiglu {
    static constexpr bool PERM = true, AFTER_DRAIN = false;
    bf16_t* H; const LAS float* tab;
    __device__ __forceinline__ void operator()(const f32x4 (&acc)[2][2][4][2], const pg8::Unit& u, int wr, int wc, int fr_, int fq_) const {
        int tl_ = threadIdx.x; asm volatile("" : "+v"(tl_)); const int fr = tl_ & 15, fq = (tl_ >> 4) & 3; (void)fr_; (void)fq_;
        const int row0 = u.pm * 256 + wr * 64 + fr, colh = u.pn * 128 + wc * 32 + 8 * fq;
#pragma unroll
        for (int ai = 0; ai < 2; ++ai)
#pragma unroll
            for (int m = 0; m < 4; ++m) {
                const int row = row0 + ai * 128 + m * 16;
                const float rs = tab[u.idx * 256 + wr * 64 + fr + ai * 128 + m * 16];
                const f32x4 a0 = acc[ai][0][m][0], a1 = acc[ai][0][m][1], b0 = acc[ai][1][m][0], b1 = acc[ai][1][m][1];
                const float nrs = rs * -1.4426950408889634f, rs2 = rs * rs;
                const f32x4 t0 = a0 * nrs, t1 = a1 * nrs;
                f32x4 e0, e1, r0, r1;
#pragma unroll
                for (int j = 0; j < 4; ++j) { e0[j] = __builtin_amdgcn_exp2f(t0[j]); e1[j] = __builtin_amdgcn_exp2f(t1[j]); }
                const f32x4 d0 = e0 + 1.0f, d1 = e1 + 1.0f;
#pragma unroll
                for (int j = 0; j < 4; ++j) { r0[j] = __builtin_amdgcn_rcpf(d0[j]); r1[j] = __builtin_amdgcn_rcpf(d1[j]); }
                const f32x4 h0 = (a0 * b0) * (r0 * rs2), h1 = (a1 * b1) * (r1 * rs2);
                u32x4 w; w.x = cvt_pk_bf16(h0[0], h0[1]); w.y = cvt_pk_bf16(h0[2], h0[3]); w.z = cvt_pk_bf16(h1[0], h1[1]); w.w = cvt_pk_bf16(h1[2], h1[3]);
                *(u32x4*)(H + (size_t)row * DFF + colh) = w;
                if (m == 3) asm volatile("" ::: "memory");
            }
    }
};
struct EpiResid {
    static constexpr bool PERM = true, AFTER_DRAIN = false;
    bf16_t* xb; float* ssq_out; float alpha;
    __device__ __forceinline__ void operator()(const f32x4 (&acc)[2][2][4][2], const pg8::Unit& u, int wr, int wc, int fr_, int fq_) const {
        int tl_ = threadIdx.x; asm volatile("" : "+v"(tl_)); const int fr = tl_ & 15, fq = (tl_ >> 4) & 3; (void)fr_; (void)fq_;
        const int row0 = u.pm * 256 + wr * 64 + fr, col0 = u.pn * 256 + wc * 32 + 8 * fq;
#pragma unroll
        for (int ai = 0; ai < 2; ++ai)
#pragma unroll
            for (int m = 0; m < 4; ++m) {
                const int row = row0 + ai * 128 + m * 16; const size_t off = (size_t)row * DM + col0; float s = 0.f;
#pragma unroll
                for (int bj = 0; bj < 2; ++bj) {
                    const u32x4 xo = *(const u32x4*)(xb + off + bj * 128);
                    f32x4 v0, v1;
                    v0[0] = __uint_as_float(xo.x << 16); v0[1] = __uint_as_float(xo.x & 0xffff0000u); v0[2] = __uint_as_float(xo.y << 16); v0[3] = __uint_as_float(xo.y & 0xffff0000u);
                    v1[0] = __uint_as_float(xo.z << 16); v1[1] = __uint_as_float(xo.z & 0xffff0000u); v1[2] = __uint_as_float(xo.w << 16); v1[3] = __uint_as_float(xo.w & 0xffff0000u);
                    v0 = v0 + acc[ai][bj][m][0] * alpha; v1 = v1 + acc[ai][bj][m][1] * alpha;
                    u32x4 w; w.x = cvt_pk_bf16(v0[0], v0[1]); w.y = cvt_pk_bf16(v0[2], v0[3]); w.z = cvt_pk_bf16(v1[0], v1[1]); w.w = cvt_pk_bf16(v1[2], v1[3]);
                    *(u32x4*)(xb + off + bj * 128) = w;
                    s += (v0[0] * v0[0] + v0[1] * v0[1]) + (v0[2] * v0[2] + v0[3] * v0[3]) + (v1[0] * v1[0] + v1[1] * v1[1]) + (v1[2] * v1[2] + v1[3] * v1[3]);
                }
                s += __shfl_xor(s, 16); s += __shfl_xor(s, 32);
                if (fq == 0) ssq_out[(size_t)row * 16 + u.pn * 4 + wc] = s;
            }
    }
};
struct EpiQK {
    static constexpr bool PERM = true, AFTER_DRAIN = false;
    bf16_t *U, *DQ, *DK, *MQ, *MK, *MV; const LAS float* tab; const float* cosT; const float* sinT; float* kmean;
    __device__ __forceinline__ void operator()(const f32x4 (&acc)[2][2][4][2], const pg8::Unit& u, int wr, int wc, int fr_, int fq_) const {
        int tl_ = threadIdx.x; asm volatile("" : "+v"(tl_)); const int fr = tl_ & 15, fq = (tl_ >> 4) & 3; (void)fr_; (void)fq_;
        const int pn = u.pn, row0 = u.pm * 256 + wr * 64 + fr, cw = wc * 32 + 8 * fq;
        if (pn == 0 || pn == 7) {
            bf16_t* Ud = pn == 0 ? U : MV;
#pragma unroll
            for (int ai = 0; ai < 2; ++ai)
#pragma unroll
                for (int m = 0; m < 4; ++m) {
                    const int row = row0 + ai * 128 + m * 16; const float rs = tab[u.idx * 256 + wr * 64 + fr + ai * 128 + m * 16];
#pragma unroll
                    for (int bj = 0; bj < 2; ++bj) {
                        const f32x4 v0 = acc[ai][bj][m][0] * rs, v1 = acc[ai][bj][m][1] * rs;
                        u32x4 w; w.x = cvt_pk_bf16(v0[0], v0[1]); w.y = cvt_pk_bf16(v0[2], v0[3]); w.z = cvt_pk_bf16(v1[0], v1[1]); w.w = cvt_pk_bf16(v1[2], v1[3]);
                        *(u32x4*)(Ud + (size_t)row * 256 + bj * 128 + cw) = w;
                    }
                    if (m == 3) asm volatile("" ::: "memory");
                }
            return;
        }
        bf16_t* base; int pitch; float qs = 1.0f;
        if (pn <= 2) { base = DQ + (pn - 1) * 256; pitch = 512; qs = QSCALE; }
        else if (pn <= 4) { base = DK + (pn - 3) * 256; pitch = 512; }
        else if (pn == 5) { base = MQ; pitch = 256; qs = QSCALE; }
        else { base = MK; pitch = 256; }
        const int i0 = 16 * (wc & 1) + 4 * fq;
        f32x4 cs[2][2];
#pragma unroll
        for (int bj = 0; bj < 2; ++bj) { cs[bj][0] = (f32x4){0.f, 0.f, 0.f, 0.f}; cs[bj][1] = (f32x4){0.f, 0.f, 0.f, 0.f}; }
#pragma unroll
        for (int ai = 0; ai < 2; ++ai)
#pragma unroll
            for (int m = 0; m < 4; ++m) {
                const int row = row0 + ai * 128 + m * 16, pos = row & (SEQ - 1);
                const float rs = qs * tab[u.idx * 256 + wr * 64 + fr + ai * 128 + m * 16];
                const f32x4 c4 = *(const f32x4*)(cosT + pos * 32 + i0), s4 = *(const f32x4*)(sinT + pos * 32 + i0);
#pragma unroll
                for (int bj = 0; bj < 2; ++bj) {
                    const f32x4 x1 = acc[ai][bj][m][0] * rs, x2 = acc[ai][bj][m][1] * rs;
                    const f32x4 o1 = x1 * c4 - x2 * s4, o2 = x2 * c4 + x1 * s4;
                    u32x4 w; w.x = cvt_pk_bf16(o1[0], o1[1]); w.y = cvt_pk_bf16(o1[2], o1[3]); w.z = cvt_pk_bf16(o2[0], o2[1]); w.w = cvt_pk_bf16(o2[2], o2[3]);
                    *(u32x4*)(base + (size_t)row * pitch + bj * 128 + cw) = w;
                    cs[bj][0] += o1; cs[bj][1] += o2;
                }
                asm volatile("" : "+v"(cs[0][0]), "+v"(cs[0][1]), "+v"(cs[1][0]), "+v"(cs[1][1]));
                if (m == 3) asm volatile("" ::: "memory");
            }
        if (pn == 6) {
#pragma unroll
            for (int bj = 0; bj < 2; ++bj)
#pragma unroll
                for (int n = 0; n < 2; ++n)
#pragma unroll
                    for (int j = 0; j < 4; ++j) {
                        float v = cs[bj][n][j];
                        v += __shfl_xor(v, 1); v += __shfl_xor(v, 2); v += __shfl_xor(v, 4); v += __shfl_xor(v, 8);
                        if (fr == 0) unsafeAtomicAdd(kmean + (size_t)u.pm * 256 + bj * 128 + cw + 4 * n + j, v);
                    }
        }
    }
};
struct EpiVt {
    static constexpr bool PERM = true, AFTER_DRAIN = false;
    bf16_t* Vt; const LAS float* tab;
    __device__ __forceinline__ void operator()(const f32x4 (&acc)[2][2][4][2], const pg8::Unit& u, int wr, int wc, int fr_, int fq_) const {
        int tl_ = threadIdx.x; asm volatile("" : "+v"(tl_)); const int fr = tl_ & 15, fq = (tl_ >> 4) & 3; (void)fr_; (void)fq_;
        const int ch0 = u.pm * 256 + wr * 64 + fr, tok0 = u.pn * 256 + wc * 32 + 8 * fq;
        f32x4 rs[2][2];
#pragma unroll
        for (int bj = 0; bj < 2; ++bj)
#pragma unroll
            for (int n = 0; n < 2; ++n) {
                rs[bj][n] = *(const LAS f32x4*)(tab + u.idx * 256 + bj * 128 + wc * 32 + 8 * fq + 4 * n);
            }
#pragma unroll
        for (int ai = 0; ai < 2; ++ai)
#pragma unroll
            for (int m = 0; m < 4; ++m) {
                const int ch = ch0 + ai * 128 + m * 16;
#pragma unroll
                for (int bj = 0; bj < 2; ++bj) {
                    const f32x4 v0 = acc[ai][bj][m][0] * rs[bj][0], v1 = acc[ai][bj][m][1] * rs[bj][1];
                    u32x4 w; w.x = cvt_pk_bf16(v0[0], v0[1]); w.y = cvt_pk_bf16(v0[2], v0[3]); w.z = cvt_pk_bf16(v1[0], v1[1]); w.w = cvt_pk_bf16(v1[2], v1[3]);
                    *(u32x4*)(Vt + (size_t)ch * MTOK + tok0 + bj * 128) = w;
                }
                if (m == 3) asm volatile("" ::: "memory");
            }
    }
};

__device__ __forceinline__ int permute64(int col) { const int base = col & ~63, d = col & 63; return base + 32 * ((d >> 4) & 1) + 8 * ((d >> 2) & 3) + 4 * (d >> 5) + (d & 3); }
__device__ __forceinline__ bf16_t* dst_row(int kind, int col, bf16_t* d0, bf16_t* d1, int K) {
    if (kind == 0) return d0 + (size_t)col * K;
    if (kind == 1) { const int half = col >= DFF ? 1 : 0, c2 = col - half * DFF; return d0 + (size_t)(256 * (c2 >> 7) + 128 * half + (c2 & 127)) * K; }
    if (col < 256) return d0 + (size_t)col * K;
    if (col < 1280) return d0 + (size_t)permute64(col) * K;
    if (col < 1792) return d1 + (size_t)(col - 1280) * K;
    if (col < 2304) return d0 + (size_t)(permute64(col) - 512) * K;
    return d0 + (size_t)(1792 + col - 2304) * K;
}
__device__ __forceinline__ void transpose_item(const float* __restrict__ W, int K, int N, const float* __restrict__ gain, int kind, bf16_t* d0, bf16_t* d1, LAS float* scr, int item, int lane) {
    const int nblk = N / 64, kb = item / nblk, nb = item % nblk, k0 = 64 * kb, n0 = 64 * nb;
    f32x4 v[16];
#pragma unroll
    for (int i = 0; i < 16; ++i) v[i] = *(const f32x4*)(W + (size_t)(k0 + 4 * i + (lane >> 4)) * N + n0 + 4 * (lane & 15));
#pragma unroll
    for (int i = 0; i < 16; ++i) { const int kk = 4 * i + (lane >> 4); const float g = gain ? gain[k0 + kk] : 1.0f; LAS float* sp = scr + kk * 65 + 4 * (lane & 15);
        sp[0] = v[i][0] * g; sp[1] = v[i][1] * g; sp[2] = v[i][2] * g; sp[3] = v[i][3] * g; }
    LDS_WAIT(); asm volatile("" ::: "memory");
    const int c = lane & 7;
#pragma unroll
    for (int j = 0; j < 8; ++j) { const int n = (lane >> 3) + 8 * j; const LAS float* sq = scr + (8 * c) * 65 + n;
        u32x4 o; o.x = cvt_pk_bf16(sq[0 * 65], sq[1 * 65]); o.y = cvt_pk_bf16(sq[2 * 65], sq[3 * 65]); o.z = cvt_pk_bf16(sq[4 * 65], sq[5 * 65]); o.w = cvt_pk_bf16(sq[6 * 65], sq[7 * 65]);
        *(u32x4*)(dst_row(kind, n0 + n, d0, d1, K) + k0 + 8 * c) = o; }
    LDS_WAIT(); asm volatile("" ::: "memory");
}

__device__ __forceinline__ int crow(int r, int hi) { return (r & 3) + 8 * (r >> 2) + 4 * hi; }
template <int KSTR> __device__ __forceinline__ void qk_tile(f32x16& p0, f32x16& p1, const LAS unsigned char* Kl, const bf16x8 (&qf)[4], int q, int hi) {
    const f32x16 z = {0.f, 0.f, 0.f, 0.f, 0.f, 0.f, 0.f, 0.f, 0.f, 0.f, 0.f, 0.f, 0.f, 0.f, 0.f, 0.f};
    __builtin_amdgcn_s_setprio(1);
#pragma unroll
    for (int s = 0; s < 4; ++s) {
        const bf16x8 a0 = *(const LAS bf16x8*)(Kl + q * KSTR + s * 32 + hi * 16);
        const bf16x8 a1 = *(const LAS bf16x8*)(Kl + (32 + q) * KSTR + s * 32 + hi * 16);
        p0 = __builtin_amdgcn_mfma_f32_32x32x16_bf16(a0, qf[s], s == 0 ? z : p0, 0, 0, 0);
        p1 = __builtin_amdgcn_mfma_f32_32x32x16_bf16(a1, qf[s], s == 0 ? z : p1, 0, 0, 0);
    }
    __builtin_amdgcn_s_setprio(0);
}
template <int NDV> __device__ __forceinline__ void softmax_step(f32x16& p0, f32x16& p1, float& m_run, float& l_run, f32x16 (&o)[NDV]) {
    float mx = fmaxf(p0[0], p1[0]);
#pragma unroll
    for (int r = 1; r < 16; ++r) mx = fmaxf(mx, fmaxf(p0[r], p1[r]));
    { const auto rr = __builtin_amdgcn_permlane32_swap(__float_as_uint(mx), __float_as_uint(mx), false, false); mx = fmaxf(__uint_as_float(rr[0]), __uint_as_float(rr[1])); }
    if (__any(mx > m_run ? 1 : 0)) {
        const float m_new = fmaxf(m_run, mx);
        const float alpha = __builtin_amdgcn_exp2f(m_run - m_new);
        l_run *= alpha; m_run = m_new;
#pragma unroll
        for (int i = 0; i < NDV; ++i) o[i] = o[i] * alpha;
    }
    float rs = 0.f;
#pragma unroll
    for (int r = 0; r < 16; ++r) { p0[r] = __builtin_amdgcn_exp2f(p0[r] - m_run); p1[r] = __builtin_amdgcn_exp2f(p1[r] - m_run); rs += p0[r] + p1[r]; }
    l_run += rs;
}
__device__ __forceinline__ void pack_p(bf16x8 (&pk)[4], const f32x16& p0, const f32x16& p1) {
#pragma unroll
    for (int s = 0; s < 2; ++s) {
        u32x4 a, b;
        a.x = cvt_pk_bf16(p0[8 * s + 0], p0[8 * s + 1]); a.y = cvt_pk_bf16(p0[8 * s + 2], p0[8 * s + 3]); a.z = cvt_pk_bf16(p0[8 * s + 4], p0[8 * s + 5]); a.w = cvt_pk_bf16(p0[8 * s + 6], p0[8 * s + 7]);
        b.x = cvt_pk_bf16(p1[8 * s + 0], p1[8 * s + 1]); b.y = cvt_pk_bf16(p1[8 * s + 2], p1[8 * s + 3]); b.z = cvt_pk_bf16(p1[8 * s + 4], p1[8 * s + 5]); b.w = cvt_pk_bf16(p1[8 * s + 6], p1[8 * s + 7]);
        pk[s] = __builtin_bit_cast(bf16x8, a); pk[2 + s] = __builtin_bit_cast(bf16x8, b);
    }
}
template <int NDV> __device__ __forceinline__ void pv_tile(f32x16 (&o)[NDV], const LAS unsigned char* Vl, const bf16x8 (&pk)[4], int q, int hi) {
    __builtin_amdgcn_s_setprio(1);
#pragma unroll
    for (int blk = 0; blk < NDV; ++blk)
#pragma unroll
        for (int ks = 0; ks < 4; ++ks) {
            const bf16x8 va = *(const LAS bf16x8*)(Vl + (32 * blk + q) * 144 + ks * 32 + hi * 16);
            o[blk] = __builtin_amdgcn_mfma_f32_32x32x16_bf16(va, pk[ks], o[blk], 0, 0, 0);
        }
    __builtin_amdgcn_s_setprio(0);
}
__device__ __forceinline__ void vt_store(LAS unsigned char* Vl, int dv, int c, u32x4 v) {
    LAS unsigned char* p = Vl + dv * 144 + (c >> 1) * 32 + (c & 1) * 8;
    *(LAS u32x2*)p = (u32x2){v.x, v.y}; *(LAS u32x2*)(p + 16) = (u32x2){v.z, v.w};
}

template <int NDV, int KSTR, bool HASNEXT, bool DIAG>
__device__ __forceinline__ void attn_step(f32x16& p0, f32x16& p1, f32x16 (&o)[NDV], float& m_run, float& l_run, const bf16x8 (&qf)[4],
                                          const LAS unsigned char* Knext, const LAS unsigned char* Vcur, int q, int hi, int kbase, int qpos, bool allowed) {
    f32x16 n0, n1;
    if (HASNEXT) qk_tile<KSTR>(n0, n1, Knext, qf, q, hi);
    if (DIAG) {
#pragma unroll
        for (int r = 0; r < 16; ++r) { const int kk = kbase + crow(r, hi); if (kk > qpos) p0[r] = -INFINITY; if (kk + 32 > qpos) p1[r] = -INFINITY; }
    }
    float mx = fmaxf(p0[0], p1[0]);
#pragma unroll
    for (int r = 1; r < 16; ++r) mx = fmaxf(mx, fmaxf(p0[r], p1[r]));
    mx = fmaxf(mx, __shfl_xor(mx, 32));
    if (!allowed) mx = -INFINITY;
    if (__any(mx > m_run ? 1 : 0)) {
        const float m_new = fmaxf(m_run, mx);
        const float alpha = __builtin_amdgcn_exp2f(m_run - m_new);
        l_run *= alpha; m_run = m_new;
#pragma unroll
        for (int i = 0; i < NDV; ++i) o[i] = o[i] * alpha;
    }
    const float m_eff = allowed ? m_run : INFINITY;
    float rs = 0.f;
#pragma unroll
    for (int r = 0; r < 16; ++r) { p0[r] = __builtin_amdgcn_exp2f(p0[r] - m_eff); p1[r] = __builtin_amdgcn_exp2f(p1[r] - m_eff); rs += p0[r] + p1[r]; }
    l_run += rs;
    bf16x8 pk[4]; pack_p(pk, p0, p1);
    pv_tile<NDV>(o, Vcur, pk, q, hi);
    if (HASNEXT) { p0 = n0; p1 = n1; }
}

constexpr int DK_STR = 272, DK_BUF = 64 * DK_STR, DV_BUF = 128 * 144;
constexpr int D_LK = 0, D_LV = 2 * DK_BUF, D_STG = D_LV + 2 * DV_BUF;
__device__ __forceinline__ void diff_unit(int b, int h, int qi, const bf16_t* DQ, const bf16_t* DK, const bf16_t* Vt, bf16_t* Y, float lam, const float* subg, float lam_init, LAS unsigned char* lds) {
    int tid_ = threadIdx.x; asm volatile("" : "+v"(tid_)); const int tid = tid_, lane = tid & 63, q = lane & 31, hi = lane >> 5; const int wid = __builtin_amdgcn_readfirstlane(tid >> 6);
    const int rg = wid & 3, map = wid >> 2;
    const int q0 = qi * 128 + rg * 32, qpos = q0 + q;
    const size_t tokb = (size_t)b * SEQ;
    bf16x8 qf[4];
    { const bf16_t* qp = DQ + (tokb + qpos) * 512 + h * 128 + map * 64 + hi * 8;
#pragma unroll
      for (int s = 0; s < 4; ++s) qf[s] = *(const bf16x8*)(qp + 16 * s); }
    const int NT = 2 * qi + 2;
    const bf16_t* kg0 = DK + (tokb + (tid >> 4)) * 512 + h * 128 + (tid & 15) * 8;
    const bf16_t* vg0 = Vt + (size_t)(h * 128 + (tid >> 3)) * MTOK + tokb + (tid & 7) * 8;
    u32x4 ka0, ka1, va0, va1, kb0, kb1, vb0, vb1;
#define D_LOAD(S, t) do { k##S##0 = *(const u32x4*)(kg0 + (size_t)(t) * 64 * 512); k##S##1 = *(const u32x4*)(kg0 + (size_t)(t) * 64 * 512 + 32 * 512); \
                          v##S##0 = *(const u32x4*)(vg0 + (t) * 64); v##S##1 = *(const u32x4*)(vg0 + (size_t)64 * MTOK + (t) * 64); } while (0)
#define D_STORE(S, buf) do { *(LAS u32x4*)(lds + D_LK + (buf) * DK_BUF + (tid >> 4) * DK_STR + (tid & 15) * 16) = k##S##0; \
                             *(LAS u32x4*)(lds + D_LK + (buf) * DK_BUF + (32 + (tid >> 4)) * DK_STR + (tid & 15) * 16) = k##S##1; \
                             vt_store(lds + D_LV + (buf) * DV_BUF, tid >> 3, tid & 7, v##S##0); vt_store(lds + D_LV + (buf) * DV_BUF, 64 + (tid >> 3), tid & 7, v##S##1); } while (0)
#define ATT_BAR() asm volatile("s_waitcnt lgkmcnt(0)\n\ts_barrier" ::: "memory")
#define D_COMPUTE(t, cur) do { if (64 * (t) <= q0 + 31) { \
            f32x16 p0, p1; \
            qk_tile<DK_STR>(p0, p1, lds + D_LK + (cur) * DK_BUF + map * 128, qf, q, hi); \
            if (64 * (t) + 63 > q0) { \
                _Pragma("unroll") for (int r = 0; r < 16; ++r) { const int kk = 64 * (t) + crow(r, hi); if (kk > qpos) p0[r] = -INFINITY; if (kk + 32 > qpos) p1[r] = -INFINITY; } } \
            softmax_step<4>(p0, p1, m_run, l_run, o); \
            bf16x8 pk[4]; pack_p(pk, p0, p1); \
            pv_tile<4>(o, lds + D_LV + (cur) * DV_BUF, pk, q, hi); } } while (0)
    float m_run = -1e30f, l_run = 0.f;
    f32x16 o[4];
#pragma unroll
    for (int i = 0; i < 4; ++i)
#pragma unroll
        for (int r = 0; r < 16; ++r) o[i][r] = 0.f;
    D_LOAD(a, 0); D_LOAD(b, 1); D_STORE(a, 0); ATT_BAR();
    for (int t = 0; t < NT; t += 2) {
        { const int tl = (t + 2 < NT) ? t + 2 : NT - 1; D_LOAD(a, tl); }
        D_COMPUTE(t, 0);
        D_STORE(b, 1);
        ATT_BAR();
        { const int tl = (t + 3 < NT) ? t + 3 : NT - 1; D_LOAD(b, tl); }
        D_COMPUTE(t + 1, 1);
        if (t + 2 < NT) D_STORE(a, 0);
        ATT_BAR();
    }
#undef D_LOAD
#undef D_STORE
#undef D_COMPUTE
    const float l_tot = l_run + __shfl_xor(l_run, 32), inv = 1.0f / l_tot;
    LAS float* ex = (LAS float*)lds + rg * 4096;
    if (map == 1) {
#pragma unroll
        for (int i = 0; i < 4; ++i)
#pragma unroll
            for (int r = 0; r < 16; ++r) ex[(i * 16 + r) * 64 + lane] = o[i][r] * inv;
    }
    __syncthreads();
    if (map == 0) {
        float ss = 0.f;
#pragma unroll
        for (int i = 0; i < 4; ++i)
#pragma unroll
            for (int r = 0; r < 16; ++r) { const float v = o[i][r] * inv - lam * ex[(i * 16 + r) * 64 + lane]; o[i][r] = v; ss += v * v; }
        ss += __shfl_xor(ss, 32);
        const float rn = (1.0f - lam_init) / sqrtf(ss * (1.0f / 128.0f) + NORM_EPS);
        LAS unsigned char* stg = lds + D_STG + rg * 8704;
#pragma unroll
        for (int i = 0; i < 4; ++i)
#pragma unroll
            for (int r4 = 0; r4 < 4; ++r4) {
                const int dv = 32 * i + 8 * r4 + 4 * hi; const f32x4 g = *(const LAS f32x4*)((const LAS float*)(lds + RSTD_TAB_OFF) + dv);
                u32x2 w; w.x = cvt_pk_bf16(o[i][4 * r4 + 0] * rn * g[0], o[i][4 * r4 + 1] * rn * g[1]); w.y = cvt_pk_bf16(o[i][4 * r4 + 2] * rn * g[2], o[i][4 * r4 + 3] * rn * g[3]);
                *(LAS u32x2*)(stg + q * 272 + dv * 2) = w;
            }
        LDS_WAIT(); asm volatile("" ::: "memory");
        bf16_t* yo = Y + (tokb + q0) * DM + 256 + h * 128;
#pragma unroll
        for (int i = 0; i < 8; ++i) { const int id = i * 64 + lane, rw = id >> 4, c = id & 15;
            const u32x4 v = *(const LAS u32x4*)(stg + rw * 272 + c * 16); *(u32x4*)(yo + (size_t)rw * DM + c * 8) = v; }
    }
    __syncthreads();
}

constexpr int MK_BUF = 64 * 144, M_LK = 0, M_LV = 2 * MK_BUF, M_STG = 4 * MK_BUF;
__device__ __forceinline__ void moba_unit(int b, int h, int qb, const bf16_t* MQ, const bf16_t* MKp, const bf16_t* Vt, const float* kmean, bf16_t* Y, LAS unsigned char* lds) {
    int tid_ = threadIdx.x; asm volatile("" : "+v"(tid_)); const int tid = tid_, lane = tid & 63, q = lane & 31, hi = lane >> 5; const int wid = __builtin_amdgcn_readfirstlane(tid >> 6);
    const int q0 = qb * 256 + wid * 32, qpos = q0 + q;
    const size_t tokb = (size_t)b * SEQ;
    bf16x8 qf[4];
    { const bf16_t* qp = MQ + (tokb + qpos) * 256 + h * 64 + hi * 8;
#pragma unroll
      for (int s = 0; s < 4; ++s) qf[s] = *(const bf16x8*)(qp + 16 * s); }
    unsigned selmask = 0u;
    {
        float g[8];
#pragma unroll
        for (int j = 0; j < 8; ++j) {
            g[j] = -INFINITY;
            if (j < qb) {
                const float* km = kmean + (size_t)(b * 8 + j) * 256 + h * 64 + hi * 8; float a = 0.f;
#pragma unroll
                for (int s = 0; s < 4; ++s) { const f32x4 k0 = *(const f32x4*)(km + 16 * s), k1 = *(const f32x4*)(km + 16 * s + 4);
#pragma unroll
                    for (int e = 0; e < 4; ++e) { a += bf2f((bf16_t)qf[s][e]) * k0[e]; a += bf2f((bf16_t)qf[s][4 + e]) * k1[e]; } }
                g[j] = a + __shfl_xor(a, 32);
            }
        }
#pragma unroll
        for (int j = 0; j < 8; ++j) {
            int rank = 0;
#pragma unroll
            for (int i = 0; i < 8; ++i) if (i != j) rank += (g[i] > g[j] || (g[i] == g[j] && i < j)) ? 1 : 0;
            if (j < qb && rank < 3) selmask |= 1u << j;
        }
    }
    const int NT = 4 * (qb + 1);
    const bf16_t* kg0 = MKp + (tokb + (tid >> 3)) * 256 + h * 64 + (tid & 7) * 8;
    const bf16_t* vg0 = Vt + (size_t)(512 + h * 64 + (tid >> 3)) * MTOK + tokb + (tid & 7) * 8;
    u32x4 ka0, va0, kb0, vb0;
#define M_LOAD(S, t) do { k##S##0 = *(const u32x4*)(kg0 + (size_t)(t) * 64 * 256); v##S##0 = *(const u32x4*)(vg0 + (t) * 64); } while (0)
#define M_STORE(S, buf) do { *(LAS u32x4*)(lds + M_LK + (buf) * MK_BUF + (tid >> 3) * 144 + (tid & 7) * 16) = k##S##0; vt_store(lds + M_LV + (buf) * MK_BUF, tid >> 3, tid & 7, v##S##0); } while (0)
#define M_COMPUTE(t, cur) do { const int j_ = (t) >> 2; const bool own_ = (j_ == qb); const bool allowed_ = own_ ? true : (((selmask >> j_) & 1u) != 0u); \
        const bool active_ = own_ ? (64 * (t) <= q0 + 31) : (__any(allowed_ ? 1 : 0) != 0); \
        if (active_) { \
            f32x16 p0, p1; \
            qk_tile<144>(p0, p1, lds + M_LK + (cur) * MK_BUF, qf, q, hi); \
            if (own_) { if (64 * (t) + 63 > q0) { \
                _Pragma("unroll") for (int r = 0; r < 16; ++r) { const int kk = 64 * (t) + crow(r, hi); if (kk > qpos) p0[r] = -INFINITY; if (kk + 32 > qpos) p1[r] = -INFINITY; } } } \
            else if (!allowed_) { _Pragma("unroll") for (int r = 0; r < 16; ++r) { p0[r] = -INFINITY; p1[r] = -INFINITY; } } \
            softmax_step<2>(p0, p1, m_run, l_run, o); \
            bf16x8 pk[4]; pack_p(pk, p0, p1); \
            pv_tile<2>(o, lds + M_LV + (cur) * MK_BUF, pk, q, hi); } } while (0)
    float m_run = -1e30f, l_run = 0.f;
    f32x16 o[2];
#pragma unroll
    for (int i = 0; i < 2; ++i)
#pragma unroll
        for (int r = 0; r < 16; ++r) o[i][r] = 0.f;
    M_LOAD(a, 0); M_STORE(a, 0); M_LOAD(b, 1); ATT_BAR();
    for (int t = 0; t < NT; t += 2) {
        { const int tl = (t + 2 < NT) ? t + 2 : NT - 1; M_LOAD(a, tl); }
        M_COMPUTE(t, 0);
        M_STORE(b, 1);
        ATT_BAR();
        { const int tl = (t + 3 < NT) ? t + 3 : NT - 1; M_LOAD(b, tl); }
        M_COMPUTE(t + 1, 1);
        if (t + 2 < NT) M_STORE(a, 0);
        ATT_BAR();
    }
#undef M_LOAD
#undef M_STORE
#undef M_COMPUTE
    const float l_tot = l_run + __shfl_xor(l_run, 32), inv = 1.0f / l_tot;
    LAS unsigned char* stg = lds + M_STG + wid * 4608;
#pragma unroll
    for (int i = 0; i < 2; ++i)
#pragma unroll
        for (int r4 = 0; r4 < 4; ++r4) {
            const int dv = 32 * i + 8 * r4 + 4 * hi;
            u32x2 w; w.x = cvt_pk_bf16(o[i][4 * r4 + 0] * inv, o[i][4 * r4 + 1] * inv); w.y = cvt_pk_bf16(o[i][4 * r4 + 2] * inv, o[i][4 * r4 + 3] * inv);
            *(LAS u32x2*)(stg + q * 144 + dv * 2) = w;
        }
    LDS_WAIT(); asm volatile("" ::: "memory");
    bf16_t* yo = Y + (tokb + q0) * DM + 768 + h * 64;
#pragma unroll
    for (int i = 0; i < 4; ++i) { const int id = i * 64 + lane, rw = id >> 3, c = id & 7;
        const u32x4 v = *(const LAS u32x4*)(stg + rw * 144 + c * 16); *(u32x4*)(yo + (size_t)rw * DM + c * 8) = v; }
    __syncthreads();
}

constexpr int PL_US = 0, PL_P16 = 40448, PL_WT = 74240, PL_PSTR = 528, PL_WSTR = 144;
__device__ __forceinline__ void pool_stage_w(const float* pw, LAS unsigned char* lds) {
    int tid_ = threadIdx.x; asm volatile("" : "+v"(tid_)); const int lane = tid_ & 63; const int wid = __builtin_amdgcn_readfirstlane(tid_ >> 6);
    const int g = wid >> 1, th = wid & 1;
    const float* wp = pw + (size_t)(g * 64 + th * 32) * 64 + lane;
    float v[32];
#pragma unroll
    for (int i = 0; i < 32; ++i) v[i] = wp[i * 64];
    LAS unsigned char* wt = lds + PL_WT + (g * 64 + lane) * PL_WSTR + th * 64;
#pragma unroll
    for (int i = 0; i < 16; ++i) *(LAS unsigned*)(wt + 4 * i) = cvt_pk_bf16(v[2 * i], v[2 * i + 1]);
}
__device__ __forceinline__ void pool_unit(int item, const bf16_t* U, const float* psc, bf16_t* Y, LAS unsigned char* lds) {
    int tid_ = threadIdx.x; asm volatile("" : "+v"(tid_)); const int tid = tid_; const int tok0 = item * 64, t0 = tok0 & (SEQ - 1);
    LAS bf16_t* Us = (LAS bf16_t*)(lds + PL_US);
    {
        u32x4 uv[5];
#pragma unroll
        for (int k = 0; k < 5; ++k) { const int id = tid + 512 * k, r = id >> 5, c = id & 31, trel = r - 15;
            uv[k] = (u32x4){0u, 0u, 0u, 0u};
            if (id < 79 * 32 && t0 + trel >= 0) uv[k] = *(const u32x4*)(U + (ptrdiff_t)(tok0 + trel) * 256 + c * 8); }
#pragma unroll
        for (int k = 0; k < 5; ++k) { const int id = tid + 512 * k; if (id < 79 * 32) *(LAS u32x4*)(Us + (id >> 5) * 256 + (id & 31) * 8) = uv[k]; }
    }
    __syncthreads();
    {
        const int c = tid & 255, hf = tid >> 8, g = c >> 6, w = 2 << g;
        const LAS bf16_t* up = Us + (15 + hf * 32) * 256 + c;
        LAS unsigned char* pp = lds + PL_P16 + (hf * 32) * PL_PSTR + c * 2;
        float s = 0.f;
        for (int k = 1; k < w; ++k) s += bf2f(up[-k * 256]);
#pragma unroll 8
        for (int i = 0; i < 32; ++i) {
            const int t = t0 + hf * 32 + i; const float ut = bf2f(up[i * 256]);
            s += ut;
            const int cnt = (t + 1 < w) ? (t + 1) : w;
            const float val = s * __builtin_amdgcn_rcpf((float)cnt) - ut;
            *(LAS bf16_t*)(pp + i * PL_PSTR) = (bf16_t)(cvt_pk_bf16(val, 0.f) & 0xffffu);
            s -= bf2f(up[(i - w + 1) * 256]);
        }
    }
    __syncthreads();
    {
        const int lane = tid & 63, q = lane & 31, hi = lane >> 5; const int wid = __builtin_amdgcn_readfirstlane(tid >> 6);
        const int g = wid >> 1, th = wid & 1;
        const LAS unsigned char* pa = lds + PL_P16 + (th * 32 + q) * PL_PSTR + (g * 64 + 8 * hi) * 2;
        const LAS unsigned char* wb = lds + PL_WT + (g * 64 + q) * PL_WSTR + 8 * hi * 2;
        const f32x16 z = {0.f, 0.f, 0.f, 0.f, 0.f, 0.f, 0.f, 0.f, 0.f, 0.f, 0.f, 0.f, 0.f, 0.f, 0.f, 0.f};
        f32x16 acc0 = z, acc1 = z;
#pragma unroll
        for (int s4 = 0; s4 < 4; ++s4) {
            const bf16x8 a = *(const LAS bf16x8*)(pa + s4 * 32);
            const bf16x8 b0 = *(const LAS bf16x8*)(wb + s4 * 32), b1 = *(const LAS bf16x8*)(wb + 32 * PL_WSTR + s4 * 32);
            acc0 = __builtin_amdgcn_mfma_f32_32x32x16_bf16(a, b0, acc0, 0, 0, 0);
            acc1 = __builtin_amdgcn_mfma_f32_32x32x16_bf16(a, b1, acc1, 0, 0, 0);
        }
        const float sc0 = psc[g * 64 + q], sc1 = psc[g * 64 + 32 + q];
        bf16_t* yo = Y + (size_t)(tok0 + th * 32) * DM + g * 64 + q;
#pragma unroll
        for (int r = 0; r < 16; ++r) { const int tk = crow(r, hi);
            yo[(size_t)tk * DM] = (bf16_t)(cvt_pk_bf16(acc0[r] * sc0, 0.f) & 0xffffu);
            yo[(size_t)tk * DM + 32] = (bf16_t)(cvt_pk_bf16(acc1[r] * sc1, 0.f) & 0xffffu); }
    }
    __syncthreads();
}

#include <hip/hip_bf16.h>
#include <cmath>
namespace moba_body {
using bf16=__hip_bfloat16;
using bf16x8=__attribute__((ext_vector_type(8)))short;
using s16x4=__attribute__((ext_vector_type(4)))short;
using f32x16=__attribute__((ext_vector_type(16)))float;
using u32x4=__attribute__((ext_vector_type(4)))unsigned;
using f32x4_t=__attribute__((ext_vector_type(4)))float;
constexpr int BATCH=16,NHEAD=4,SEQ=2048,D=64,DM=NHEAD*D,OP=1024,OCOL=768;
constexpr int NW=8,QBLK=32,QB=QBLK*NW,KVBLK=64,NQB=SEQ/QB;
constexpr int ATTN_PITCH=DM, ATTN_UNIT_ROWS=QB;
__device__ __forceinline__ int crow(int r,int hi){return (r&3)+8*(r>>2)+4*hi;}
#define SBAR() __builtin_amdgcn_sched_barrier(0)
__device__ __forceinline__ void cmask(f32x16&p0,f32x16&p1,int jb,int qrel,int hi){
  const float NEG=-INFINITY; int kb=64*jb+4*hi;
  #pragma unroll
  for(int r=0;r<16;++r){int kv=kb+(r&3)+8*(r>>2); if(kv>qrel)p0[r]=NEG; if(kv+32>qrel)p1[r]=NEG;}
}

constexpr int NSLOT=3, SLOTB=8192;
constexpr int LDS_K=0, LDS_V=NSLOT*SLOTB, LDS_WS=2*NSLOT*SLOTB, LDS_OST=LDS_WS+NW*64*4, LDS_BYTES=LDS_OST+NW*4096;
constexpr float C2=0.125f*1.4426950408889634f;
__device__ __forceinline__ void glds16(const void*gsrc,unsigned lds_dst){unsigned keep;
  asm volatile("s_mov_b32 %0, m0\n\ts_mov_b32 m0, %2\n\ts_nop 0\n\tglobal_load_lds_dwordx4 %1, off\n\ts_mov_b32 m0, %0":"=&s"(keep):"v"(gsrc),"s"(lds_dst):"memory");}
__device__ __forceinline__ float max3f(float a,float b,float c){float r;asm("v_max3_f32 %0, %1, %2, %3":"=v"(r):"v"(a),"v"(b),"v"(c));return r;}
__device__ __forceinline__ float max2f(float a,float b){float r;asm("v_max_f32_e32 %0, %1, %2":"=v"(r):"v"(a),"v"(b));return r;}
__device__ __forceinline__ float fadd_s(float a,float b){float r;asm("v_add_f32_e32 %0, %1, %2":"=v"(r):"v"(a),"v"(b));return r;}
__device__ __forceinline__ float fsub_s(float a,float b){float r;asm("v_sub_f32_e32 %0, %1, %2":"=v"(r):"v"(a),"v"(b));return r;}
typedef float f32x2_t __attribute__((ext_vector_type(2))); typedef __bf16 bf16x2_t __attribute__((ext_vector_type(2)));
__device__ __forceinline__ unsigned cvtpk_s(float lo,float hi){f32x2_t v={lo,hi};bf16x2_t b=__builtin_convertvector(v,bf16x2_t);return __builtin_bit_cast(unsigned,b);}
#define WAIT_BAR(N) asm volatile("s_waitcnt vmcnt(" #N ") lgkmcnt(0)\n\ts_barrier":::"memory")

__device__ __forceinline__ void qkt(f32x16&p0,f32x16&p1,const char*Kslot,const bf16x8*qr,int r32,int hi){ const f32x16 zf={0.f,0.f,0.f,0.f,0.f,0.f,0.f,0.f,0.f,0.f,0.f,0.f,0.f,0.f,0.f,0.f};
  const char*kb=Kslot+hi*1024+r32*16;
  #pragma unroll
  for(int d0=0;d0<4;++d0){
    const bf16x8 b0=*reinterpret_cast<const bf16x8*>(kb+d0*2048);
    const bf16x8 b1=*reinterpret_cast<const bf16x8*>(kb+d0*2048+512);
    if(d0==0){p0=__builtin_amdgcn_mfma_f32_32x32x16_bf16(b0,qr[0],zf,0,0,0);p1=__builtin_amdgcn_mfma_f32_32x32x16_bf16(b1,qr[0],zf,0,0,0);}
    else{p0=__builtin_amdgcn_mfma_f32_32x32x16_bf16(b0,qr[d0],p0,0,0,0);p1=__builtin_amdgcn_mfma_f32_32x32x16_bf16(b1,qr[d0],p1,0,0,0);}}
}
typedef __attribute__((address_space(3))) const char* lds_cptr;
typedef short v4i16_t __attribute__((ext_vector_type(4)));
__device__ __forceinline__ void kload8(bf16x8*kf,lds_cptr kp){
  kf[0]=*(const __attribute__((address_space(3))) bf16x8*)(kp);      kf[1]=*(const __attribute__((address_space(3))) bf16x8*)(kp+512);
  kf[2]=*(const __attribute__((address_space(3))) bf16x8*)(kp+2048); kf[3]=*(const __attribute__((address_space(3))) bf16x8*)(kp+2560);
  kf[4]=*(const __attribute__((address_space(3))) bf16x8*)(kp+4096); kf[5]=*(const __attribute__((address_space(3))) bf16x8*)(kp+4608);
  kf[6]=*(const __attribute__((address_space(3))) bf16x8*)(kp+6144); kf[7]=*(const __attribute__((address_space(3))) bf16x8*)(kp+6656);
}
__device__ __forceinline__ void kload2(bf16x8*kf,lds_cptr kp,int j){ kf[2*j]=*(const __attribute__((address_space(3))) bf16x8*)(kp+j*2048); kf[2*j+1]=*(const __attribute__((address_space(3))) bf16x8*)(kp+j*2048+512); }
__device__ __forceinline__ s16x4 vtr(lds_cptr p){ return __builtin_bit_cast(s16x4,__builtin_amdgcn_ds_read_tr16_b64_v4i16((__attribute__((address_space(3))) v4i16_t*)p)); }
__device__ __forceinline__ float rowmax(const f32x16&p0,const f32x16&p1){
  float a=max3f(p0[0],p0[1],p1[0]),b=max3f(p0[2],p0[3],p1[1]);a=max3f(a,p1[2],p1[3]);
  #pragma unroll
  for(int r=4;r<16;r+=4){a=max3f(a,p0[r],p0[r+1]);b=max3f(b,p0[r+2],p0[r+3]);a=max3f(a,p1[r],p1[r+1]);b=max3f(b,p1[r+2],p1[r+3]);}
  const float m=max2f(a,b);
  auto rr=__builtin_amdgcn_permlane32_swap(__float_as_uint(m),__float_as_uint(m),false,false);
  return max2f(__uint_as_float(rr[0]),__uint_as_float(rr[1]));
}
__device__ __forceinline__ void pv(f32x16*o,int vb,bf16x8 pa0,bf16x8 pa1,bf16x8 pa2,bf16x8 pa3){
  #pragma unroll
  for(int d0=0;d0<2;++d0){s16x4 lo[4],hi[4];
    #pragma unroll
    for(int ks=0;ks<4;++ks){
      asm volatile("ds_read_b64_tr_b16 %0,%1 offset:%c2":"=&v"(lo[ks]):"v"(vb),"i"(d0*4096+ks*1024):"memory");
      asm volatile("ds_read_b64_tr_b16 %0,%1 offset:%c2":"=&v"(hi[ks]):"v"(vb),"i"(d0*4096+ks*1024+512):"memory");}
    asm volatile("s_waitcnt lgkmcnt(0)":::"memory");SBAR();
    #define PK(k) (bf16x8){lo[k][0],lo[k][1],lo[k][2],lo[k][3],hi[k][0],hi[k][1],hi[k][2],hi[k][3]}
    o[d0]=__builtin_amdgcn_mfma_f32_32x32x16_bf16(pa0,PK(0),o[d0],0,0,0);
    o[d0]=__builtin_amdgcn_mfma_f32_32x32x16_bf16(pa1,PK(1),o[d0],0,0,0);
    o[d0]=__builtin_amdgcn_mfma_f32_32x32x16_bf16(pa2,PK(2),o[d0],0,0,0);
    o[d0]=__builtin_amdgcn_mfma_f32_32x32x16_bf16(pa3,PK(3),o[d0],0,0,0);
    #undef PK
  }
}

#ifndef ATTN_STORE16
#define ATTN_STORE16(p,v) (*(u32x4*)(p)=(v))
#endif
template<int THRL> __device__ __forceinline__ void attn_unit(int b,int h,int qb,const bf16*Q,const bf16*__restrict__ K,const bf16*__restrict__ V,bf16*O,char*shm,const float*__restrict__ kmean){
  int tid_=threadIdx.x; asm volatile("":"+v"(tid_)); const int tid=tid_,lane=tid&63,r32=lane&31,hi=lane>>5; const int wid=__builtin_amdgcn_readfirstlane(tid>>6);
  const long rowbase=(long)b*SEQ; const int q0=qb*QB;
  const bf16*Qw=Q+(rowbase+q0+wid*QBLK)*DM+h*D;
  const bf16*Kh=K+rowbase*DM+h*D,*Vh=V+rowbase*DM+h*D;
  const unsigned lds0=(unsigned)(uintptr_t)shm;
  float*wsf=(float*)(shm+LDS_WS)+wid*64;
  const bf16*ksrc=Kh+(long)lane*DM+wid*8;
  const bf16*vsrc=Vh+(long)(16*(wid&3)+(lane>>2))*DM+(wid>>2)*32+(lane&3)*8;
  const unsigned kdst=lds0+LDS_K+wid*1024, vdst=lds0+LDS_V+wid*1024;
  #define DMA_K(t,slot) glds16(ksrc+(long)(t)*KVBLK*DM,(unsigned)__builtin_amdgcn_readfirstlane(kdst+(slot)))
  #define DMA_V(t,slot) glds16(vsrc+(long)(t)*KVBLK*DM,(unsigned)__builtin_amdgcn_readfirstlane(vdst+(slot)))
  const int vb0=(int)(lds0+LDS_V)+((lane>>4)&1)*32+(lane&3)*8+(4*hi+((lane&15)>>2))*64;
  const char*Kbase=shm+LDS_K; bf16x8 kf[8];
  const lds_cptr shm3=(lds_cptr)shm; const lds_cptr kp0=shm3+LDS_K+hi*1024+r32*16; const lds_cptr vp0=shm3+LDS_V+((lane>>4)&1)*32+(lane&3)*8+(4*hi+((lane&15)>>2))*64;
  const int NT=(q0+QB)/KVBLK;
  DMA_K(0,0);DMA_V(0,0);DMA_K(1,SLOTB);
  bf16x8 qr[4];
  #pragma unroll
  for(int d0=0;d0<4;++d0)qr[d0]=*reinterpret_cast<const bf16x8*>(&Qw[(long)r32*DM+d0*16+hi*8]);
  unsigned selmask=0u; const bool gate_any=(qb>3);
  if(gate_any){ float g_[8];
    #pragma unroll
    for(int j=0;j<8;++j){ g_[j]=-INFINITY;
      if(j<qb){ const float*km=kmean+(size_t)(b*8+j)*256+h*64+hi*8; float a_=0.f;
        #pragma unroll
        for(int s_=0;s_<4;++s_){ const f32x4_t k0=*(const f32x4_t*)(km+16*s_),k1=*(const f32x4_t*)(km+16*s_+4);
          #pragma unroll
          for(int e=0;e<4;++e){ a_+=__uint_as_float((unsigned)(unsigned short)qr[s_][e]<<16)*k0[e]; a_+=__uint_as_float((unsigned)(unsigned short)qr[s_][4+e]<<16)*k1[e]; } }
        g_[j]=a_+__shfl_xor(a_,32); } }
    #pragma unroll
    for(int j=0;j<8;++j){ int rank=0;
      #pragma unroll
      for(int i=0;i<8;++i) if(i!=j) rank+=(g_[i]>g_[j]||(g_[i]==g_[j]&&i<j))?1:0;
      if(j<qb&&rank<3) selmask|=1u<<j; } }
  else selmask=0xffu;
  #define GATE(P0,P1,t) do{ if(gate_any){ const bool al_=((selmask>>((t)>>2))&1u)!=0u; if(!al_){ _Pragma("unroll") for(int r=0;r<16;++r){P0[r]=-INFINITY;P1[r]=-INFINITY;} } } }while(0)
  float mhat=0.f,l_reg=0.f;f32x16 o[2];o[0]=f32x16{};o[1]=f32x16{};const f32x16 zf={0.f,0.f,0.f,0.f,0.f,0.f,0.f,0.f,0.f,0.f,0.f,0.f,0.f,0.f,0.f,0.f};
  const int qrel=wid*QBLK+r32;
  #define CMASK(P0,P1,t) do{int jb_=(t)-(NT-4); if(jb_>=0)cmask(P0,P1,jb_,qrel,hi); else GATE(P0,P1,t);}while(0)
  bool resc=false;
  #define START(P0,P1) do{ const float rm=rowmax(P0,P1); resc=false; \
    { const float dl=(rm>-1e30f)?rm:0.f; mhat=fadd_s(mhat,dl); \
      _Pragma("unroll") for(int r=0;r<16;++r){P0[r]=fsub_s(P0[r],dl);P1[r]=fsub_s(P1[r],dl);} \
      } \
    _Pragma("unroll") for(int r=0;r<16;++r)P0[r]=__builtin_amdgcn_exp2f(P0[r]); }while(0)
  #define RESC() do{ if(resc){ asm volatile("s_waitcnt lgkmcnt(0)":::"memory"); \
      _Pragma("unroll") for(int d_=0;d_<2;++d_) _Pragma("unroll") for(int r=0;r<16;++r)o[d_][r]*=wsf[crow(r,hi)]; } }while(0)
  f32x16 pA0,pA1,pB0,pB1;
  int sl_prev=0,sl_cur=0,sl_next=SLOTB;
  #define ROT() do{sl_prev=sl_cur;sl_cur=sl_next;sl_next=(sl_next==(NSLOT-1)*SLOTB)?0:sl_next+SLOTB;}while(0)
  DMA_K(2,2*SLOTB);
  WAIT_BAR(3);
  qkt(pA0,pA1,Kbase,qr,r32,hi);asm volatile("s_nop 15\n\ts_nop 7":"+v"(pA0),"+v"(pA1));CMASK(pA0,pA1,0);
  START(pA0,pA1);
  _Pragma("unroll") for(int r=0;r<16;++r)pA1[r]=__builtin_amdgcn_exp2f(pA1[r]);
  WAIT_BAR(0);
  DMA_K(3,0);DMA_V(1,SLOTB);
  ROT();
  kload8(kf,kp0+sl_cur);
  WAIT_BAR(2);
  s16x4 vlo[8],vhi[8]; u32x4 pw0,pw1,pw2,pw3;
  #define PKW(P,B) cvtpk_s(P[B],P[B+1])
  #define PAF(k) __builtin_bit_cast(bf16x8,pw##k)
  #define VFR(i) (bf16x8){vlo[i][0],vlo[i][1],vlo[i][2],vlo[i][3],vhi[i][0],vhi[i][1],vhi[i][2],vhi[i][3]}
  #define PIN(x) asm volatile("":"+v"(x))
  #define MX3(a,b,c) __builtin_fmaxf(__builtin_fmaxf((a),(b)),(c))
  #define GAPA(MF,A0,A1,A2,A3,W0,W1,PW) do{ MF; sacc+=A0; sacc+=A1; sacc+=A2; sacc+=A3; PIN(sacc); W0; W1; PIN(PW); SBAR(); }while(0)
  #define EX(v) __builtin_amdgcn_exp2f(v)
  #define GAPB(MF,X,B) do{ MF; X[B]=EX(X[B]-mhat); X[B+1]=EX(X[B+1]-mhat); X[B+2]=EX(X[B+2]-mhat); X[B+3]=EX(X[B+3]-mhat); PIN(X); SBAR(); }while(0)
  #define VRD(i) do{ vlo[i]=vtr(vp_+(((i)>>2)*4096+((i)&3)*1024)); vhi[i]=vtr(vp_+(((i)>>2)*4096+((i)&3)*1024+512)); }while(0)
  #define KRD(G,j) do{ if(G){ kload2(kf,kp0+sl_next,j); SBAR(); } }while(0)
  #define STEP(C0,C1,P0,P1,t,GK,GV,GL) do{ SBAR(); \
    const lds_cptr vp_=vp0+sl_prev; \
    VRD(0); SBAR(); float sacc=(P0[0]+P0[1]); \
    GAPA(C0=__builtin_amdgcn_mfma_f32_32x32x16_bf16(kf[0],qr[0],zf,0,0,0), P0[2],P0[3],P0[4],P0[5],     pw0[0]=PKW(P0,0), pw0[1]=PKW(P0,2), pw0); \
    VRD(4); SBAR(); GAPA(C1=__builtin_amdgcn_mfma_f32_32x32x16_bf16(kf[1],qr[0],zf,0,0,0), P0[6],P0[7],P0[8],P0[9],     pw0[2]=PKW(P0,4), pw0[3]=PKW(P0,6), pw0); \
    VRD(1); SBAR(); GAPA(C0=__builtin_amdgcn_mfma_f32_32x32x16_bf16(kf[2],qr[1],C0,0,0,0),   P0[10],P0[11],P0[12],P0[13], pw1[0]=PKW(P0,8), pw1[1]=PKW(P0,10), pw1); \
    VRD(5); SBAR(); GAPA(C1=__builtin_amdgcn_mfma_f32_32x32x16_bf16(kf[3],qr[1],C1,0,0,0),   P0[14],P0[15],P1[0],P1[1],   pw1[2]=PKW(P0,12),pw1[3]=PKW(P0,14), pw1); \
    VRD(2); SBAR(); GAPA(C0=__builtin_amdgcn_mfma_f32_32x32x16_bf16(kf[4],qr[2],C0,0,0,0),   P1[2],P1[3],P1[4],P1[5],     pw2[0]=PKW(P1,0), pw2[1]=PKW(P1,2), pw2); \
    VRD(6); SBAR(); GAPA(C1=__builtin_amdgcn_mfma_f32_32x32x16_bf16(kf[5],qr[2],C1,0,0,0),   P1[6],P1[7],P1[8],P1[9],     pw2[2]=PKW(P1,4), pw2[3]=PKW(P1,6), pw2); \
    VRD(3); SBAR(); GAPA(C0=__builtin_amdgcn_mfma_f32_32x32x16_bf16(kf[6],qr[3],C0,0,0,0),   P1[10],P1[11],P1[12],P1[13], pw3[0]=PKW(P1,8), pw3[1]=PKW(P1,10), pw3); \
    VRD(7); SBAR(); GAPA(C1=__builtin_amdgcn_mfma_f32_32x32x16_bf16(kf[7],qr[3],C1,0,0,0),   P1[14],P1[15],0.f,0.f,       pw3[2]=PKW(P1,12),pw3[3]=PKW(P1,14), pw3); \
    l_reg+=sacc; \
    if(GK){DMA_K((t)+3,sl_cur);} if(GV){DMA_V((t)+1,sl_next);} \
    CMASK(C0,C1,t); \
    { float a=MX3(C0[0],C0[1],C1[0]),b=MX3(C0[2],C0[3],C1[1]); a=MX3(a,C1[2],C1[3]); \
      _Pragma("unroll") for(int r=4;r<16;r+=4){a=MX3(a,C0[r],C0[r+1]);b=MX3(b,C0[r+2],C0[r+3]);a=MX3(a,C1[r],C1[r+1]);b=MX3(b,C1[r+2],C1[r+3]);} \
      float rm=__builtin_fmaxf(a,b); { auto rr=__builtin_amdgcn_permlane32_swap(__float_as_uint(rm),__float_as_uint(rm),false,false); rm=__builtin_fmaxf(__uint_as_float(rr[0]),__uint_as_float(rr[1])); } \
      rm-=mhat; resc=false; \
      if(__builtin_expect(__any(rm>(float)THRL),0)){ const float dl=__builtin_fmaxf(rm,0.f); mhat+=dl; \
        const float f=__builtin_amdgcn_exp2f(-dl); l_reg*=f; if(hi==0)wsf[r32]=f; resc=true; } } \
    SBAR(); \
    GAPB(o[0]=__builtin_amdgcn_mfma_f32_32x32x16_bf16(PAF(0),VFR(0),o[0],0,0,0), C0,0); \
    GAPB(o[1]=__builtin_amdgcn_mfma_f32_32x32x16_bf16(PAF(0),VFR(4),o[1],0,0,0), C0,4); \
    KRD(GL,0); GAPB(o[0]=__builtin_amdgcn_mfma_f32_32x32x16_bf16(PAF(1),VFR(1),o[0],0,0,0), C0,8); \
    KRD(GL,1); GAPB(o[1]=__builtin_amdgcn_mfma_f32_32x32x16_bf16(PAF(1),VFR(5),o[1],0,0,0), C0,12); \
    KRD(GL,2); GAPB(o[0]=__builtin_amdgcn_mfma_f32_32x32x16_bf16(PAF(2),VFR(2),o[0],0,0,0), C1,0); \
    KRD(GL,3); GAPB(o[1]=__builtin_amdgcn_mfma_f32_32x32x16_bf16(PAF(2),VFR(6),o[1],0,0,0), C1,4); \
    GAPB(o[0]=__builtin_amdgcn_mfma_f32_32x32x16_bf16(PAF(3),VFR(3),o[0],0,0,0), C1,8); \
    GAPB(o[1]=__builtin_amdgcn_mfma_f32_32x32x16_bf16(PAF(3),VFR(7),o[1],0,0,0), C1,12); \
    }while(0)
  int t=1;
  #undef CMASK
  #define CMASK(P0,P1,t) GATE(P0,P1,t)
  for(;t+5<NT;t+=2){
    STEP(pB0,pB1,pA0,pA1,t,true,true,true);     WAIT_BAR(2); RESC(); ROT();
    STEP(pA0,pA1,pB0,pB1,t+1,true,true,true);   WAIT_BAR(2); RESC(); ROT();
  }
  #undef CMASK
  #define CMASK(P0,P1,t) do{int jb_=(t)-(NT-4); if(jb_>=0)cmask(P0,P1,jb_,qrel,hi); else GATE(P0,P1,t);}while(0)
  #define ENDW(tt) do{ if((tt)+3<NT){WAIT_BAR(2);} else if((tt)+2<NT){WAIT_BAR(1);} else {WAIT_BAR(0);} }while(0)
  for(;t+1<NT;t+=2){
    STEP(pB0,pB1,pA0,pA1,t,(t+3<NT),(t+1<NT),(t+1<NT));       ENDW(t);   RESC(); ROT();
    STEP(pA0,pA1,pB0,pB1,t+1,(t+4<NT),(t+2<NT),(t+2<NT));     ENDW(t+1); RESC(); ROT();
  }
  STEP(pB0,pB1,pA0,pA1,NT-1,false,false,false); RESC();
  { float sacc=pB0[0]+pB0[1]; _Pragma("unroll") for(int r=2;r<16;++r)sacc+=pB0[r]; _Pragma("unroll") for(int r=0;r<16;++r)sacc+=pB1[r]; l_reg+=sacc;
    pw0=(u32x4){PKW(pB0,0),PKW(pB0,2),PKW(pB0,4),PKW(pB0,6)};pw1=(u32x4){PKW(pB0,8),PKW(pB0,10),PKW(pB0,12),PKW(pB0,14)};pw2=(u32x4){PKW(pB1,0),PKW(pB1,2),PKW(pB1,4),PKW(pB1,6)};pw3=(u32x4){PKW(pB1,8),PKW(pB1,10),PKW(pB1,12),PKW(pB1,14)};
    SBAR(); pv(o,vb0+sl_cur,PAF(0),PAF(1),PAF(2),PAF(3)); }
  #undef PKW
  #undef PAF
  #undef VFR
  #undef PIN
  #undef MX3
  #undef GAPA
  #undef GAPB
  #undef EX
  #undef VRD
  #undef KRD
  #undef STEP
  #undef ENDW
  {auto rr=__builtin_amdgcn_permlane32_swap(__float_as_uint(l_reg),__float_as_uint(l_reg),false,false);l_reg=__uint_as_float(rr[0])+__uint_as_float(rr[1]);}
  if(hi==0)wsf[32+r32]=l_reg;asm volatile("s_waitcnt lgkmcnt(0)":::"memory");
  float rli[16];
  #pragma unroll
  for(int r=0;r<16;++r)rli[r]=__builtin_amdgcn_rcpf(wsf[32+crow(r,hi)]);
  bf16*Ow=O+(rowbase+q0+wid*QBLK)*OP+OCOL+h*D;
  { bf16*stg=(bf16*)(shm+LDS_OST)+wid*2048;
    #pragma unroll
    for(int r=0;r<16;++r){const int orow=crow(r,hi);
      #pragma unroll
      for(int d0=0;d0<2;++d0)stg[orow*64+d0*32+r32]=__float2bfloat16(o[d0][r]*rli[r]);}
    asm volatile("s_waitcnt lgkmcnt(0)":::"memory");
    #pragma unroll
    for(int i=0;i<4;++i){const int row=i*8+(lane>>3),ch=lane&7; const u32x4 v=*(const u32x4*)(stg+row*64+ch*8); ATTN_STORE16(Ow+(long)row*OP+ch*8,v);} }
  asm volatile("s_waitcnt lgkmcnt(0)\n\ts_barrier":::"memory");
  #undef DMA_K
  #undef DMA_V
  #undef GATE
  #undef CMASK
  #undef START
  #undef RESC
  #undef ROT
}
constexpr int ATTN_LDS_BYTES=LDS_BYTES;
#undef SBAR
#undef WAIT_BAR
}

#define XB_TMO      128
#define XB_XCNT(j)  (256  + 64 * (j))
#define XB_XSUB(j)  (1280 + 64 * (j))
#define XB_XGEN(j)  (2304 + 64 * (j))
#define XB_TOP      3328
#define XB_TOPGEN   3392
#define XCD_BAR_WORDS 3456
#define XB_SPIN_CAP (1u << 18)

__device__ __forceinline__ unsigned xb_ld(unsigned* p)              { return __hip_atomic_load(p, __ATOMIC_RELAXED, __HIP_MEMORY_SCOPE_AGENT); }
__device__ __forceinline__ unsigned xb_add(unsigned* p, unsigned v) { return __hip_atomic_fetch_add(p, v, __ATOMIC_RELAXED, __HIP_MEMORY_SCOPE_AGENT); }
__device__ __forceinline__ unsigned xb_xcc_id() { return (unsigned)__builtin_amdgcn_s_getreg((3 << 11) | 20) & 0xFu; }
#define XB_SPIN(cond, bar) do { unsigned _sp = 0; while (cond) { __builtin_amdgcn_s_sleep(1); \
    if ((++_sp & 255u) == 0u) { if (xb_ld(&(bar)[XB_TMO])) break; if (_sp > XB_SPIN_CAP) { atomicAdd(&(bar)[XB_TMO], 1u); break; } } } } while (0)

struct XcdBarrier {
    unsigned* bar; unsigned x;
    volatile LAS unsigned* st;
};

__device__ __forceinline__ XcdBarrier xcd_barrier_post(unsigned* bar, volatile LAS unsigned* st) {
    XcdBarrier b; b.bar = bar; b.x = xb_xcc_id(); b.st = st;
    if (threadIdx.x == 0) (void)xb_add(&bar[XB_XCNT(b.x)], 1u);
    return b;
}
__device__ __forceinline__ void xcd_barrier_complete(unsigned* bar, unsigned x, unsigned& nloc, unsigned& nx) {
    const unsigned G = gridDim.x * gridDim.y * gridDim.z;
    unsigned sum, cnt, mine, sp = 0u;
    for (;;) {
        sum = 0u; cnt = 0u; mine = 0u;
#pragma unroll
        for (unsigned j = 0; j < 16; ++j) { const unsigned c = xb_ld(&bar[XB_XCNT(j)]); sum += c; cnt += (c > 0u) ? 1u : 0u; mine = (j == x) ? c : mine; }
        if (sum == G) break;
        __builtin_amdgcn_s_sleep(1);
        if ((++sp & 255u) == 0u) { if (xb_ld(&bar[XB_TMO])) break; if (sp > XB_SPIN_CAP) { atomicAdd(&bar[XB_TMO], 1u); break; } }
    }
    nloc = mine > 0u ? mine : 1u; nx = cnt > 0u ? cnt : 1u;
}

__device__ __forceinline__ void xcd_barrier(const XcdBarrier& b) {
    asm volatile("s_waitcnt vmcnt(0)" ::: "memory");
    __syncthreads();
    if (threadIdx.x == 0) {
        unsigned* bar = b.bar;
        __builtin_amdgcn_s_waitcnt(0);
        unsigned nloc = b.st[0], nx = b.st[1];
        if (nloc == 0u) { xcd_barrier_complete(bar, b.x, nloc, nx); b.st[0] = nloc; b.st[1] = nx; }
        const unsigned old = xb_add(&bar[XB_XSUB(b.x)], 1u);
        const unsigned gen = old / nloc;
        if (old + 1u == (gen + 1u) * nloc) {
            __builtin_amdgcn_fence(__ATOMIC_RELEASE, "agent");
            asm volatile("s_waitcnt vmcnt(0)" ::: "memory");
            const unsigned og = xb_add(&bar[XB_TOP], 1u);
            const unsigned tg = og / nx;
            if (og + 1u == (tg + 1u) * nx) xb_add(&bar[XB_TOPGEN], 1u);
            else XB_SPIN(xb_ld(&bar[XB_TOPGEN]) == tg, bar);
            __builtin_amdgcn_fence(__ATOMIC_ACQUIRE, "agent");
            xb_add(&bar[XB_XGEN(b.x)], 1u);
            asm volatile("s_waitcnt vmcnt(0)" ::: "memory");
        } else {
            XB_SPIN(xb_ld(&bar[XB_XGEN(b.x)]) == gen, bar);
            __builtin_amdgcn_fence(__ATOMIC_ACQUIRE, "agent");
            asm volatile("s_waitcnt vmcnt(0)" ::: "memory");
        }
    }
    __syncthreads();
}

struct Params { const float* in[15]; float* out; unsigned char* ws; float inv_freq[32]; float lam_init[2]; int pad[2]; };
enum { I_X = 0, I_F1N, I_F1WI, I_F1WO, I_MN, I_MWI, I_MWO, I_PW, I_PS, I_DL, I_DS, I_F2N, I_F2WI, I_F2WO, I_FN };

__global__ void __launch_bounds__(512, 2) fwd_megakernel(Params p) {
    extern __shared__ __attribute__((aligned(16))) unsigned char lds_raw[];
    LAS unsigned char* lds = (LAS unsigned char*)lds_raw;
    cg::grid_group grid = cg::this_grid();
    if (threadIdx.x < 2) ((volatile LAS unsigned*)(lds + LDS_BYTES - 64))[threadIdx.x] = 0u;
    __syncthreads();
    if (p.ws == nullptr) grid.sync();
    XcdBarrier xbar = xcd_barrier_post((unsigned*)(p.ws + WS_SSQ) + 7 * MTOK, (volatile LAS unsigned*)(lds + LDS_BYTES - 64));
#define GRID_BAR() xcd_barrier(xbar)
    const int tid = threadIdx.x, lane = tid & 63; const int wave = __builtin_amdgcn_readfirstlane(tid >> 6);
    const int G = gridDim.x, bx = blockIdx.x, vcu = (G % 8 == 0) ? (bx % 8) * (G / 8) + bx / 8 : bx;
    const int gw = vcu * 8 + wave, NGW = G * 8;
    unsigned char* ws = p.ws;
    float* zreg = (float*)(ws + WS_SSQ); float* ssq = (float*)(ws + WS_SSQ16); float* kmean = (float*)(ws + WS_KMEAN);
    float* cosT = (float*)(ws + WS_COS); float* sinT = (float*)(ws + WS_SIN);
    bf16_t* XB = (bf16_t*)(ws + WS_XB); bf16_t* H = (bf16_t*)(ws + WS_H);
    bf16_t* U = (bf16_t*)(ws + WS_U); bf16_t* DQ = (bf16_t*)(ws + WS_DQ); bf16_t* DKb = (bf16_t*)(ws + WS_DK); bf16_t* MQ = (bf16_t*)(ws + WS_MQ); bf16_t* MKb = (bf16_t*)(ws + WS_MK);
    bf16_t* VT = (bf16_t*)(ws + WS_VT); bf16_t* MV = (bf16_t*)(ws + WS_MV); bf16_t* Y = (bf16_t*)(ws + WS_Y);
    float* out = p.out;

#ifdef PROBE_PRO2
    for (int rep_ = 0; rep_ < 2; ++rep_)
#endif
    {
        LAS float* scr = (LAS float*)(lds + wave * 16640);
        constexpr int I_W1 = (DM / 64) * (2 * DFF / 64), I_W2 = (DFF / 64) * (DM / 64), I_MI = (DM / 64) * (2560 / 64), I_MO = (DM / 64) * (DM / 64);
        constexpr int PER_LAYER = 2 * I_W1 + 2 * I_W2 + I_MI + I_MO;
        for (int it = gw; it < DEPTH * PER_LAYER; it += NGW) {
            const int l = it / PER_LAYER; int r = it % PER_LAYER;
            unsigned char* wl = ws + WS_W + (size_t)l * W_LAYER;
            if (r < I_W1) { transpose_item(p.in[I_F1WI] + (size_t)l * DM * 2 * DFF, DM, 2 * DFF, p.in[I_F1N] + l * DM, 1, (bf16_t*)(wl + WO_W1A), nullptr, scr, r, lane); continue; } r -= I_W1;
            if (r < I_W1) { transpose_item(p.in[I_F2WI] + (size_t)l * DM * 2 * DFF, DM, 2 * DFF, p.in[I_F2N] + l * DM, 1, (bf16_t*)(wl + WO_W1B), nullptr, scr, r, lane); continue; } r -= I_W1;
            if (r < I_W2) { transpose_item(p.in[I_F1WO] + (size_t)l * DFF * DM, DFF, DM, nullptr, 0, (bf16_t*)(wl + WO_W2A), nullptr, scr, r, lane); continue; } r -= I_W2;
            if (r < I_W2) { transpose_item(p.in[I_F2WO] + (size_t)l * DFF * DM, DFF, DM, nullptr, 0, (bf16_t*)(wl + WO_W2B), nullptr, scr, r, lane); continue; } r -= I_W2;
            if (r < I_MI) { transpose_item(p.in[I_MWI] + (size_t)l * DM * 2560, DM, 2560, p.in[I_MN] + l * DM, 2, (bf16_t*)(wl + WO_WQK), (bf16_t*)(wl + WO_WV), scr, r, lane); continue; } r -= I_MI;
            transpose_item(p.in[I_MWO] + (size_t)l * DM * DM, DM, DM, nullptr, 0, (bf16_t*)(wl + WO_WO), nullptr, scr, r, lane);
        }
        const float* x = p.in[I_X];
        for (int m0 = gw; m0 < MTOK; m0 += 4 * NGW) {
            f32x4 v[4][4]; float sq4[4];
#pragma unroll
            for (int k = 0; k < 4; ++k) { const f32x4* xr = (const f32x4*)(x + (size_t)(m0 + k * NGW) * DM) + lane;
#pragma unroll
                for (int j = 0; j < 4; ++j) v[k][j] = xr[64 * j]; }
#pragma unroll
            for (int k = 0; k < 4; ++k) { float s = 0.f;
#pragma unroll
                for (int j = 0; j < 4; ++j) s += (v[k][j][0] * v[k][j][0] + v[k][j][1] * v[k][j][1]) + (v[k][j][2] * v[k][j][2] + v[k][j][3] * v[k][j][3]);
                sq4[k] = wave_sum(s); }
#pragma unroll
            for (int k = 0; k < 4; ++k) { const int m = m0 + k * NGW; u32x2* o8 = (u32x2*)(XB + (size_t)m * DM) + lane;
#pragma unroll
                for (int j = 0; j < 4; ++j) { u32x2 w; w.x = cvt_pk_bf16(v[k][j][0], v[k][j][1]); w.y = cvt_pk_bf16(v[k][j][2], v[k][j][3]); o8[64 * j] = w; }
                if (lane < 16) ssq[(size_t)m * 16 + lane] = lane == 0 ? sq4[k] : 0.f; }
        }
        for (int idx = gw * 64 + lane; idx < SEQ * 32; idx += NGW * 64) {
            const int pos = idx >> 5, i = idx & 31; const float ang = (float)pos * p.inv_freq[i];
            double rev = (double)ang * 0.15915494309189535; rev -= floor(rev); const float fr = (float)rev;
            cosT[idx] = __builtin_amdgcn_cosf(fr); sinT[idx] = __builtin_amdgcn_sinf(fr);
        }
        for (int idx = gw * 64 + lane; idx < 2 * 128 * 256; idx += NGW * 64) kmean[idx] = 0.f;
    }
    GRID_BAR();

#ifdef PROBE_SYNC16
    for (int rep_ = 0; rep_ < 16; ++rep_) GRID_BAR();
#endif
#pragma unroll 1
    for (int l = 0; l < DEPTH; ++l) {
        unsigned char* wl = ws + WS_W + (size_t)l * W_LAYER;
        float* kml = kmean + (size_t)l * 128 * 256;
        { pg8::Gemm g{XB, (const bf16_t*)(wl + WO_W1A), MTOK, 2 * DFF, DM}; asm volatile("" : "+s"(g.A), "+s"(g.Bt)); pg8::StaticOrder S; S.init(MTOK, 2 * DFF, G, bx);
          LAS float* tab = (LAS float*)(lds + RSTD_TAB_OFF); build_rstd_tab<false>(tab, ssq + (size_t)(3 * l) * MTOK * 16, S); __syncthreads();
          EpiSwiglu E{H, tab};
#ifdef PROBE_FFNIN2
          for (int rep_ = 0; rep_ < 2; ++rep_)
#endif
#ifndef NO_EPISWIGLU
          pg8::gemm_phase<EpiSwiglu, pg8::StaticOrder, PG8_ALIGN, PG8_SP2>(lds, g, S, E);
#endif
        }
        GRID_BAR();
        { pg8::Gemm g{H, (const bf16_t*)(wl + WO_W2A), MTOK, DM, DFF}; asm volatile("" : "+s"(g.A), "+s"(g.Bt)); pg8::StaticOrder S; S.init(MTOK, DM, G, bx);
          EpiResid E{XB, ssq + (size_t)(3 * l + 1) * MTOK * 16, 0.5f};
#ifndef NO_EPIRESID
          pg8::gemm_phase<EpiResid, pg8::StaticOrder, PG8_ALIGN, PG8_SP2>(lds, g, S, E);
#endif
        }
        GRID_BAR();
        { pg8::Gemm g{XB, (const bf16_t*)(wl + WO_WQK), MTOK, NQK, DM}; asm volatile("" : "+s"(g.A), "+s"(g.Bt)); pg8::StaticOrder S; S.init(MTOK, NQK, G, bx);
          LAS float* tab = (LAS float*)(lds + RSTD_TAB_OFF); build_rstd_tab<false>(tab, ssq + (size_t)(3 * l + 1) * MTOK * 16, S);
          { pg8::StaticOrder S2; S2.init(NVC, MTOK, G, (bx + G / 2) % G); build_rstd_tab<true>(tab + 8 * 256, ssq + (size_t)(3 * l + 1) * MTOK * 16, S2); }
          __syncthreads();
          EpiQK E{U, DQ, DKb, MQ, MKb, MV, tab, cosT, sinT, kml};
#ifndef NO_EPIQK
          pg8::gemm_phase<EpiQK, pg8::StaticOrder, PG8_ALIGN, PG8_SP2>(lds, g, S, E);
#endif
        }
        { pg8::Gemm g{(const bf16_t*)(wl + WO_WV), XB, NVC, MTOK, DM}; asm volatile("" : "+s"(g.A), "+s"(g.Bt)); pg8::StaticOrder S; S.init(NVC, MTOK, G, (bx + G / 2) % G);
          EpiVt E{VT, (const LAS float*)(lds + RSTD_TAB_OFF) + 8 * 256};
#ifndef NO_EPIVT
          pg8::gemm_phase<EpiVt, pg8::StaticOrder, PG8_ALIGN, PG8_SP2>(lds, g, S, E);
#endif
        }
        GRID_BAR();
        {
#ifdef PROBE_ATTN2
            for (int rep_ = 0; rep_ < 2; ++rep_) {
#else
            {
#endif
            const float* lamw = p.in[I_DL] + l * 256; const float* subg = p.in[I_DS] + l * 128; const float lam_init = p.lam_init[l];
            { int ts_ = threadIdx.x; asm volatile("" : "+v"(ts_)); if (ts_ < 128) ((LAS float*)(lds + RSTD_TAB_OFF))[ts_] = subg[ts_]; }
            float la_ = 0.f, lc_ = 0.f;
            for (int i = 0; i < 64; ++i) { la_ += lamw[i] * lamw[64 + i]; lc_ += lamw[128 + i] * lamw[192 + i]; }
            const float lam = __builtin_amdgcn_exp2f(la_ * 1.4426950408889634f) - __builtin_amdgcn_exp2f(lc_ * 1.4426950408889634f) + lam_init;
#ifdef PROBE_DIFF2
            for (int rep2_ = 0; rep2_ < 2; ++rep2_)
#endif
            for (int it = vcu; it < 512; it += G) {
                const int bh = it >> 3, s = it & 7;
#ifndef NO_DIFF
                diff_unit(bh >> 2, bh & 3, 15 - s, DQ, DKb, VT, Y, lam, subg, lam_init, lds);
                diff_unit(bh >> 2, bh & 3, s, DQ, DKb, VT, Y, lam, subg, lam_init, lds);
#endif
            }
#ifdef PROBE_MOBA2
            for (int rep2_ = 0; rep2_ < 2; ++rep2_)
#endif
            for (int it = vcu; it < 256; it += G) {
                const int bh = it >> 2, s = it & 3;
#ifndef NO_MOBA
                moba_body::attn_unit<8>(bh >> 2, bh & 3, 7 - s, (const moba_body::bf16*)MQ, (const moba_body::bf16*)MKb, (const moba_body::bf16*)MV, (moba_body::bf16*)Y, (char*)lds_raw, kml);
                moba_body::attn_unit<8>(bh >> 2, bh & 3, s, (const moba_body::bf16*)MQ, (const moba_body::bf16*)MKb, (const moba_body::bf16*)MV, (moba_body::bf16*)Y, (char*)lds_raw, kml);
#endif
            }
#ifndef NO_POOL
            pool_stage_w(p.in[I_PW] + l * 4 * 64 * 64, lds);
            for (int it = vcu; it < MTOK / 64; it += G) pool_unit(it, U, p.in[I_PS] + l * 256, Y, lds);
#endif
            }
        }
        GRID_BAR();
        { pg8::Gemm g{Y, (const bf16_t*)(wl + WO_WO), MTOK, DM, DM}; asm volatile("" : "+s"(g.A), "+s"(g.Bt)); pg8::StaticOrder S; S.init(MTOK, DM, G, bx);
          EpiResid E{XB, ssq + (size_t)(3 * l + 2) * MTOK * 16, 1.0f};
#ifndef NO_EPIRESID
          pg8::gemm_phase<EpiResid, pg8::StaticOrder, PG8_ALIGN, PG8_SP2>(lds, g, S, E);
#endif
        }
        GRID_BAR();
        { pg8::Gemm g{XB, (const bf16_t*)(wl + WO_W1B), MTOK, 2 * DFF, DM}; asm volatile("" : "+s"(g.A), "+s"(g.Bt)); pg8::StaticOrder S; S.init(MTOK, 2 * DFF, G, bx);
          LAS float* tab = (LAS float*)(lds + RSTD_TAB_OFF); build_rstd_tab<false>(tab, ssq + (size_t)(3 * l + 2) * MTOK * 16, S); __syncthreads();
          EpiSwiglu E{H, tab};
#ifndef NO_EPISWIGLU
          pg8::gemm_phase<EpiSwiglu, pg8::StaticOrder, PG8_ALIGN, PG8_SP2>(lds, g, S, E);
#endif
        }
        GRID_BAR();
        { pg8::Gemm g{H, (const bf16_t*)(wl + WO_W2B), MTOK, DM, DFF}; asm volatile("" : "+s"(g.A), "+s"(g.Bt)); pg8::StaticOrder S; S.init(MTOK, DM, G, bx);
          EpiResid E{XB, ssq + (size_t)(3 * l + 3) * MTOK * 16, 0.5f};
#ifndef NO_EPIRESID
          pg8::gemm_phase<EpiResid, pg8::StaticOrder, PG8_ALIGN, PG8_SP2>(lds, g, S, E);
#endif
        }
        GRID_BAR();
    }
    {
        const float* fg = p.in[I_FN]; const float* sq = ssq + (size_t)(3 * DEPTH) * MTOK * 16;
        int tl_ = threadIdx.x; asm volatile("" : "+v"(tl_)); const int lane = tl_ & 63;
        for (int m0 = gw; m0 < MTOK; m0 += 4 * NGW) {
            u32x2 w[4][4]; float rs[4];
#pragma unroll
            for (int k = 0; k < 4; ++k) { const int m = m0 + k * NGW; const u32x2* xr = (const u32x2*)(XB + (size_t)m * DM) + lane;
#pragma unroll
                for (int j = 0; j < 4; ++j) w[k][j] = xr[64 * j];
                rs[k] = row_rstd(sq, m); }
#pragma unroll
            for (int k = 0; k < 4; ++k) { const int m = m0 + k * NGW; f32x4* orow = (f32x4*)(out + (size_t)m * DM) + lane; const f32x4* gr = (const f32x4*)fg + lane;
#pragma unroll
                for (int j = 0; j < 4; ++j) { const f32x4 g4 = gr[64 * j]; f32x4 v;
                    v[0] = __uint_as_float(w[k][j].x << 16); v[1] = __uint_as_float(w[k][j].x & 0xffff0000u); v[2] = __uint_as_float(w[k][j].y << 16); v[3] = __uint_as_float(w[k][j].y & 0xffff0000u);
                    orow[64 * j] = v * rs[k] * g4; } }
        }
    }
}

extern "C" void kernel_launch(void* const* d_in, const int* in_sizes, int n_in, void* d_out, int out_size, void* d_ws, size_t ws_size, hipStream_t stream) {
    static int grid = 0;
    if (grid == 0) {
        if (n_in != 15 || in_sizes[0] != MTOK * DM || out_size != MTOK * DM || ws_size < WS_TOTAL) { fprintf(stderr, "kernel_launch: unexpected shapes / workspace (n_in %d, ws %zu)\n", n_in, ws_size); grid = -1; return; }
        int dev = 0, cus = 0, per_cu = 0;
        hipGetDevice(&dev); hipDeviceGetAttribute(&cus, hipDeviceAttributeMultiprocessorCount, dev);
        if (hipFuncSetAttribute((const void*)fwd_megakernel, hipFuncAttributeMaxDynamicSharedMemorySize, LDS_BYTES) != hipSuccess) { fprintf(stderr, "kernel_launch: hipFuncSetAttribute failed\n"); grid = -1; return; }
        if (hipOccupancyMaxActiveBlocksPerMultiprocessor(&per_cu, (const void*)fwd_megakernel, 512, LDS_BYTES) != hipSuccess || per_cu < 1) per_cu = 1;
        (void)hipGetLastError();
        grid = cus * per_cu;
        if (grid != 256) { fprintf(stderr, "kernel_launch: built for a 256-workgroup cooperative grid (got %d)\n", grid); grid = -1; return; }
    }
    if (grid < 0) return;
    Params p{};
    for (int i = 0; i < 15; ++i) p.in[i] = (const float*)d_in[i];
    p.out = (float*)d_out; p.ws = (unsigned char*)d_ws;
    for (int i = 0; i < 32; ++i) p.inv_freq[i] = powf(10000.0f, -(float)(2 * i) / 64.0f);
    for (int l = 0; l < 2; ++l) p.lam_init[l] = (float)(0.8 - 0.6 * exp(-0.3 * (double)l));
    if (hipMemsetAsync((char*)d_ws + WS_SSQ + (size_t)7 * MTOK * 4, 0, XCD_BAR_WORDS * 4, stream) != hipSuccess) { fprintf(stderr, "kernel_launch: memset of the barrier words failed\n"); return; }
    void* args[] = {&p};
    hipError_t e = hipLaunchCooperativeKernel((const void*)fwd_megakernel, dim3(grid), dim3(512), args, LDS_BYTES, stream);
    if (e != hipSuccess) fprintf(stderr, "cooperative launch failed: %s (grid %d)\n", hipGetErrorString(e), grid);
}
```
